# Optimizing an MI355X kernel written in HIP

```python
import jax, jax.numpy as jnp
from jax import lax
import numpy as np

D_MODEL = 2048
BATCH = 16
SEQ = 2048
DEPTH = 4

HEAD_DIM = 128
N_HEADS_NA = 6
N_HEADS_DIL = 6
N_HEADS_MEM = 4
W_NA = N_HEADS_NA * HEAD_DIM
W_DIL = N_HEADS_DIL * HEAD_DIM
W_MEM = N_HEADS_MEM * HEAD_DIM
MIX_WIDTH = W_NA + W_DIL + W_MEM
IN_SPLITS = (W_NA,) * 4 + (W_DIL,) * 4 + (W_MEM,) * 2
IN_COLS = sum(IN_SPLITS)
N_MEM = 256
GRID_W = 64
NA_WIN_ROWS = 8
NA_WIN_COLS = 16
NA_QCOL_BLOCK = 16
NA_KCOL_BLOCK = 32
DIL_CONFIGS = ((128, 1), (512, 4), (2048, 16))
ROPE_THETA = 10000.0
EPS = 1e-6
NEG = -1e30
SCALE = HEAD_DIM ** -0.5

kernel_name = "hybrid_natten_dilated_memory_encoder"


def rms_norm(x, g):
    xf = x.astype(jnp.float32)
    y = xf * lax.rsqrt(jnp.mean(xf * xf, axis=-1, keepdims=True) + EPS)
    return (y * g.astype(jnp.float32)).astype(x.dtype)


def rope(x, pos):
    half = HEAD_DIM // 2
    inv = ROPE_THETA ** (-jnp.arange(half, dtype=jnp.float32) / half)
    ang = pos.astype(jnp.float32)[:, None] * inv[None, :]
    cos = jnp.cos(ang)[None, :, None, :]
    sin = jnp.sin(ang)[None, :, None, :]
    xf = x.astype(jnp.float32)
    x1, x2 = xf[..., :half], xf[..., half:]
    return jnp.concatenate([x1 * cos - x2 * sin, x2 * cos + x1 * sin], axis=-1).astype(x.dtype)


def neighbourhood_attention(q, k, v, rpb):
    B, T, H, hd = q.shape
    rows = T // GRID_W
    win_r = min(NA_WIN_ROWS, rows)
    n_cb = GRID_W // NA_QCOL_BLOCK

    def grid(a):
        return a.reshape(B, rows, GRID_W, H, hd).transpose(1, 0, 3, 2, 4)

    qg, kg, vg = grid(q), grid(k), grid(v)
    qcol = np.arange(GRID_W).reshape(n_cb, NA_QCOL_BLOCK)
    kstart = np.clip(np.arange(n_cb) * NA_QCOL_BLOCK - NA_WIN_COLS // 2, 0, GRID_W - NA_KCOL_BLOCK)
    kcol = kstart[:, None] + np.arange(NA_KCOL_BLOCK)[None, :]
    cstart = np.clip(qcol - NA_WIN_COLS // 2, 0, GRID_W - NA_WIN_COLS)
    col_ok = (kcol[:, None, :] >= cstart[:, :, None]) & (kcol[:, None, :] < cstart[:, :, None] + NA_WIN_COLS)
    dc_idx = np.clip(kcol[:, None, :] - qcol[:, :, None], -(NA_WIN_COLS - 1), NA_WIN_COLS - 1) + NA_WIN_COLS - 1
    rpb32 = rpb.astype(jnp.float32)

    def one_row(r):
        rs = jnp.clip(r - win_r // 2, 0, rows - win_r)
        k_rows = lax.dynamic_slice_in_dim(kg, rs, win_r, axis=0)
        v_rows = lax.dynamic_slice_in_dim(vg, rs, win_r, axis=0)
        k_blk = k_rows[:, :, :, kcol]
        v_blk = v_rows[:, :, :, kcol]
        q_blk = qg[r].reshape(B, H, n_cb, NA_QCOL_BLOCK, hd)
        s = jnp.einsum('bhcqd,wbhcjd->bhcqwj', q_blk, k_blk).astype(jnp.float32) * SCALE
        dr_idx = rs + jnp.arange(win_r) - r + NA_WIN_ROWS - 1
        bias = rpb32[:, dr_idx[None, None, :, None], dc_idx[:, :, None, :]]
        s = jnp.where(col_ok[:, :, None, :], s + bias[None], NEG)
        p = jax.nn.softmax(s.reshape(B, H, n_cb, NA_QCOL_BLOCK, win_r * NA_KCOL_BLOCK), axis=-1)
        p = p.reshape(s.shape).astype(v.dtype)
        o = jnp.einsum('bhcqwj,wbhcjd->bhcqd', p, v_blk)
        return o.reshape(B, H, GRID_W, hd)

    out = lax.map(one_row, jnp.arange(rows))
    return out.transpose(1, 0, 3, 2, 4).reshape(B, T, H, hd)


def banded_attention(q, k, v, half):
    lead = q.shape[:-2]
    L, hd = q.shape[-2], q.shape[-1]
    nb = -(-L // half)
    Lp = nb * half
    nl = len(lead)
    qb = jnp.pad(q, [(0, 0)] * nl + [(0, Lp - L), (0, 0)]).reshape(*lead, nb, half, hd)

    def key_blocks(a):
        c = jnp.pad(a, [(0, 0)] * nl + [(half, Lp - L + half), (0, 0)]).reshape(*lead, nb + 2, half, hd)
        return jnp.concatenate([c[..., :-2, :, :], c[..., 1:-1, :, :], c[..., 2:, :, :]], axis=-2)

    kb, vb = key_blocks(k), key_blocks(v)
    qpos = np.arange(Lp).reshape(nb, half)
    kpos = (np.arange(nb)[:, None] - 1) * half + np.arange(3 * half)[None, :]
    ok = (np.abs(kpos[:, None, :] - qpos[:, :, None]) <= half) & (kpos[:, None, :] >= 0) & (kpos[:, None, :] < L)
    s = jnp.einsum('...nqd,...nkd->...nqk', qb, kb).astype(jnp.float32) * SCALE
    s = jnp.where(ok, s, NEG)
    lse = jax.nn.logsumexp(s, axis=-1)
    p = jnp.exp(s - lse[..., None]).astype(v.dtype)
    o = jnp.einsum('...nqk,...nkd->...nqd', p, vb)
    return o.reshape(*lead, Lp, hd)[..., :L, :], lse.reshape(*lead, Lp)[..., :L]


def dilated_attention(q, k, v):
    B, T, H, hd = q.shape
    outs, lses = [], []
    for window, dil in DIL_CONFIGS:
        half = (window // 2) // dil
        L = T // dil

        def stream(a):
            return a.reshape(B, L, dil, H, hd).transpose(0, 2, 3, 1, 4)

        o, lse = banded_attention(stream(q), stream(k), stream(v), half)
        outs.append(o.transpose(0, 3, 1, 2, 4).reshape(B, T, H, hd))
        lses.append(lse.transpose(0, 3, 1, 2).reshape(B, T, H))
    w = jax.nn.softmax(jnp.stack(lses), axis=0)
    out = jnp.sum(w[..., None] * jnp.stack(outs).astype(jnp.float32), axis=0)
    return out.astype(q.dtype)


def memory_attention(q, mk, mv):
    s = jnp.einsum('bthd,bmhd->bhtm', q, mk).astype(jnp.float32) * SCALE
    p = jax.nn.softmax(s, axis=-1).astype(mv.dtype)
    return jnp.einsum('bhtm,bmhd->bthd', p, mv)


def setup_inputs(seed: int = 0) -> dict:
    key = jax.random.key(seed)
    ks = jax.random.split(key, 10)
    f32 = jnp.float32
    x = jax.random.normal(ks[0], (BATCH, SEQ, D_MODEL), f32)
    mem = jax.random.normal(ks[1], (BATCH, N_MEM, D_MODEL), f32)
    norm_g = 1.0 + 0.02 * jax.random.normal(ks[2], (DEPTH, D_MODEL), f32)
    w_in = jax.random.normal(ks[3], (DEPTH, D_MODEL, IN_COLS), f32) * D_MODEL ** -0.5
    na_rpb = 0.02 * jax.random.normal(ks[4], (DEPTH, N_HEADS_NA, 2 * NA_WIN_ROWS - 1, 2 * NA_WIN_COLS - 1), f32)
    mem_norm_g = 1.0 + 0.02 * jax.random.normal(ks[5], (D_MODEL,), f32)
    w_mem_kv = jax.random.normal(ks[6], (DEPTH, D_MODEL, 2 * W_MEM), f32) * D_MODEL ** -0.5
    w_out = jax.random.normal(ks[7], (DEPTH, MIX_WIDTH, D_MODEL), f32) * MIX_WIDTH ** -0.5
    final_g = 1.0 + 0.02 * jax.random.normal(ks[8], (D_MODEL,), f32)
    return {"x": x, "mem": mem, "norm_g": norm_g, "w_in": w_in, "na_rpb": na_rpb,
            "mem_norm_g": mem_norm_g, "w_mem_kv": w_mem_kv, "w_out": w_out, "final_g": final_g}


def reference(x, mem, norm_g, w_in, na_rpb, mem_norm_g, w_mem_kv, w_out, final_g):
    B, T, _ = x.shape
    pos = jnp.arange(T)
    offsets = np.cumsum(IN_SPLITS)[:-1].tolist()
    mem_n = rms_norm(mem, mem_norm_g)

    def heads(a, n):
        return a.reshape(a.shape[0], a.shape[1], n, HEAD_DIM)

    for l in range(DEPTH):
        h = rms_norm(x, norm_g[l])
        z = h @ w_in[l]
        na_q, na_k, na_v, na_g, dl_q, dl_k, dl_v, dl_g, m_q, m_g = jnp.split(z, offsets, axis=-1)
        o_na = neighbourhood_attention(heads(na_q, N_HEADS_NA), heads(na_k, N_HEADS_NA),
                                       heads(na_v, N_HEADS_NA), na_rpb[l]).reshape(B, T, W_NA)
        o_dl = dilated_attention(rope(heads(dl_q, N_HEADS_DIL), pos), rope(heads(dl_k, N_HEADS_DIL), pos),
                                 heads(dl_v, N_HEADS_DIL)).reshape(B, T, W_DIL)
        mk, mv = jnp.split(mem_n @ w_mem_kv[l], 2, axis=-1)
        o_m = memory_attention(heads(m_q, N_HEADS_MEM), heads(mk, N_HEADS_MEM),
                               heads(mv, N_HEADS_MEM)).reshape(B, T, W_MEM)
        y = jnp.concatenate([o_na * jax.nn.silu(na_g), o_dl * jax.nn.silu(dl_g), o_m * jax.nn.silu(m_g)], axis=-1)
        x = x + y @ w_out[l]
    return rms_norm(x, final_g)
```

```cpp
#include <hip/hip_runtime.h>
#include <hip/hip_cooperative_groups.h>
#include <cstdio>
#include <cstdint>
namespace cg = cooperative_groups;
namespace pg8 {
#define PG8_LAS __attribute__((address_space(3)))
typedef unsigned short bf16_t;
typedef short bf16x8 __attribute__((ext_vector_type(8)));
typedef float f32x4 __attribute__((ext_vector_type(4)));
typedef unsigned u32x4 __attribute__((ext_vector_type(4)));
constexpr int BM = 256, BK = 64, HALF = 128, HTB = HALF * BK * 2  , STAGE_BYTES = 8 * HTB, NXCD = 8, WGM = 8;

__host__ __device__ __forceinline__ int lds_byte(int r, int c) { const int st = (r >> 4) * 2 + (c >> 5), rr = r & 15, cc = c & 31, ob = rr * 64 + cc * 2; return st * 1024 + (ob ^ (((ob >> 9) & 1) << 5)); }
__host__ __device__ __forceinline__ void stage_rc(int b, int& R, int& C) { const int st = b / 1024, sb = b % 1024, swz = sb ^ (((sb >> 9) & 1) << 5); R = (st >> 1) * 16 + swz / 64; C = (st & 1) * 32 + (swz % 64) / 2; }
__host__ __device__ __forceinline__ int perm32(int rho) { const int n = rho >> 4, i = rho & 15; return 8 * (i >> 2) + 4 * n + (i & 3); }

struct Unit { int pm, pn; };
struct Gemm { const bf16_t* A; const bf16_t* Bt; int M, N, K; };

struct StaticOrder {
    int nM, nN, nwg, G, c;
    __host__ __device__ void init(int M, int N, int G_, int c_) { nM = M / BM; nN = N / BM; nwg = nM * nN; G = G_; c = c_; }
    __host__ __device__ bool next(int i, Unit& u) const {
        const long L = (long)i * G + c; if (L >= nwg) return false;
        int wgid = (int)L; { const int q = nwg / NXCD, r = nwg % NXCD, xcd = wgid % NXCD, off = wgid / NXCD; wgid = (xcd < r ? xcd * (q + 1) : r * (q + 1) + (xcd - r) * q) + off; }
        const int nig = WGM * nN, gid = wgid / nig, fm = gid * WGM, gsz = (nM - fm) < WGM ? (nM - fm) : WGM;
        u.pm = fm + ((wgid % nig) % gsz); u.pn = (wgid % nig) / gsz; return true;
    }
    __device__ __forceinline__ void a_ready(const Unit&) const {}
    __device__ __forceinline__ void done(const Unit&) const {}
};

__device__ __forceinline__ unsigned cvt_pk_bf16(float lo, float hi) { unsigned r; asm volatile("v_cvt_pk_bf16_f32 %0, %1, %2" : "=v"(r) : "v"(lo), "v"(hi)); return r; }

struct EpiBf16 {
    static constexpr bool PERM = true, AFTER_DRAIN = false;
    bf16_t* O; int ldc;
    __device__ __forceinline__ void operator()(const f32x4 (&acc)[2][2][4][2], const Unit& u, int wr, int wc, int fr, int fq) const {
        const int row0 = u.pm * BM + wr * 64 + fr; const int col0 = u.pn * BM + wc * 32 + 8 * fq;
#pragma unroll
        for (int ai = 0; ai < 2; ++ai)
#pragma unroll
            for (int m = 0; m < 4; ++m) { bf16_t* rowp = O + (size_t)(row0 + ai * HALF + m * 16) * ldc + col0;
#pragma unroll
                for (int bj = 0; bj < 2; ++bj) { const f32x4 v0 = acc[ai][bj][m][0], v1 = acc[ai][bj][m][1];
                    u32x4 w; w.x = cvt_pk_bf16(v0[0], v0[1]); w.y = cvt_pk_bf16(v0[2], v0[3]); w.z = cvt_pk_bf16(v1[0], v1[1]); w.w = cvt_pk_bf16(v1[2], v1[3]);
                    *(u32x4*)(rowp + bj * HALF) = w; } }
    }
};

struct EpiZ {
    static constexpr bool PERM = true, AFTER_DRAIN = false;
    bf16_t* Z; const float* ropeC; const float* ropeS;
    __device__ __forceinline__ void operator()(const f32x4 (&acc)[2][2][4][2], const Unit& u, int wr, int wc, int fr, int fq) const {
        const int row0 = u.pm * BM + wr * 64 + fr; const int col0 = u.pn * BM + wc * 32 + 8 * fq;
        const bool rope = (u.pn >= 12 && u.pn < 18);
        const int i0 = wc * 16 + 4 * fq;
#pragma unroll
        for (int ai = 0; ai < 2; ++ai)
#pragma unroll
            for (int m = 0; m < 4; ++m) { const int row = row0 + ai * HALF + m * 16; bf16_t* rowp = Z + (size_t)row * 7168 + col0;
                f32x4 c4 = (f32x4){1.f, 1.f, 1.f, 1.f}, s4 = (f32x4){0.f, 0.f, 0.f, 0.f};
                if (rope) { const int pos = row & 2047; c4 = *(const f32x4*)(ropeC + pos * 64 + i0); s4 = *(const f32x4*)(ropeS + pos * 64 + i0); }
#pragma unroll
                for (int bj = 0; bj < 2; ++bj) { const f32x4 v0 = acc[ai][bj][m][0], v1 = acc[ai][bj][m][1];
                    const float a0 = v0[0] * c4[0] - v0[1] * s4[0], b0 = v0[1] * c4[0] + v0[0] * s4[0];
                    const float a1 = v0[2] * c4[1] - v0[3] * s4[1], b1 = v0[3] * c4[1] + v0[2] * s4[1];
                    const float a2 = v1[0] * c4[2] - v1[1] * s4[2], b2 = v1[1] * c4[2] + v1[0] * s4[2];
                    const float a3 = v1[2] * c4[3] - v1[3] * s4[3], b3 = v1[3] * c4[3] + v1[2] * s4[3];
                    u32x4 w; w.x = cvt_pk_bf16(a0, b0); w.y = cvt_pk_bf16(a1, b1); w.z = cvt_pk_bf16(a2, b2); w.w = cvt_pk_bf16(a3, b3);
                    *(u32x4*)(rowp + bj * HALF) = w; }
                __builtin_amdgcn_sched_barrier(0); }
    }
};


template <class Epi, class Sched, bool ALIGN_EPI = false, bool SP2 = false>
__device__ __forceinline__ void gemm_phase(PG8_LAS unsigned char* lds, const Gemm g, const Sched& S, const Epi& E, int tid_in) {
    int tid_o = tid_in; asm volatile("" : "+v"(tid_o));
    const int tid = tid_o, wid = __builtin_amdgcn_readfirstlane(tid >> 6), lane = tid & 63, wr = wid >> 2, wc = wid & 3, fr = lane & 15, fq = lane >> 4;
    const int K = g.K, nt = K / BK;
    unsigned voffA[2], voffB[2];
#pragma unroll
    for (int i = 0; i < 2; ++i) { int R, C; stage_rc(tid * 16 + i * 8192, R, C); const int Rb = Epi::PERM ? ((R & ~31) + perm32(R & 31)) : R;
        voffA[i] = (unsigned)(R * K + C) * 2u; voffB[i] = (unsigned)(Rb * K + C) * 2u; }
    const size_t kstep = (size_t)(BK * 2);
    const size_t hstep = (size_t)HALF * K * 2;
    const size_t tstep = 2 * hstep;
    const unsigned ldsw = (unsigned)wid * 1024u;
    const int aoff = lds_byte(wr * 64 + fr, fq * 8), boff = lds_byte(wc * 32 + fr, fq * 8);
#define PG8_SA(b, h) (((b) * 2 + (h)) * HTB)
#define PG8_SB(b, h) ((4 + (b) * 2 + (h)) * HTB)
#define PG8_STAGE(bufoff, gbase, voff) do { _Pragma("unroll") for (int _i = 0; _i < 2; ++_i) \
        __builtin_amdgcn_global_load_lds((const unsigned*)((const char*)(gbase) + (voff)[_i]), (PG8_LAS unsigned*)(lds + (bufoff) + ldsw + _i * 8192), 16, 0, 0); } while (0)
#define PG8_LDA(dst, b, h) do { _Pragma("unroll") for (int m = 0; m < 4; ++m) _Pragma("unroll") for (int k = 0; k < 2; ++k) dst[m][k] = *(const PG8_LAS bf16x8*)(lds + PG8_SA(b, h) + aoff + m * 2048 + k * 1024); } while (0)
#define PG8_LDB(dst, b, h) do { _Pragma("unroll") for (int n = 0; n < 2; ++n) _Pragma("unroll") for (int k = 0; k < 2; ++k) dst[n][k] = *(const PG8_LAS bf16x8*)(lds + PG8_SB(b, h) + boff + n * 2048 + k * 1024); } while (0)
#define PG8_MMA(ai, bj, At, Bt) do { __builtin_amdgcn_s_setprio(1); _Pragma("unroll") for (int m = 0; m < 4; ++m) _Pragma("unroll") for (int n = 0; n < 2; ++n) _Pragma("unroll") for (int k = 0; k < 2; ++k) \
        acc[ai][bj][m][n] = __builtin_amdgcn_mfma_f32_16x16x32_bf16(Bt[n][k], At[m][k], acc[ai][bj][m][n], 0, 0, 0); __builtin_amdgcn_s_setprio(0); } while (0)
#define PG8_WAIT_V(n) asm volatile("s_waitcnt vmcnt(" #n ")" ::: "memory")
#define PG8_WAIT_L(n) asm volatile("s_waitcnt lgkmcnt(" #n ")" ::: "memory")
#define PG8_BAR __builtin_amdgcn_s_barrier()
#define PG8_SCHED __builtin_amdgcn_sched_barrier(0)
    Unit cur, nxt; int ui = 0;
    if (!S.next(0, cur)) return;
    f32x4 acc[2][2][4][2];
#pragma unroll
    for (int a = 0; a < 2; ++a)
#pragma unroll
        for (int b = 0; b < 2; ++b)
#pragma unroll
            for (int m = 0; m < 4; ++m)
#pragma unroll
                for (int n = 0; n < 2; ++n) acc[a][b][m][n] = (f32x4){0.f, 0.f, 0.f, 0.f};
    bf16x8 At[4][2], B0[2][2], B1[2][2];
    const char* cA = (const char*)g.A + (size_t)cur.pm * tstep; const char* cB = (const char*)g.Bt + (size_t)cur.pn * tstep;
    S.a_ready(cur);
    if constexpr (SP2) {
        PG8_STAGE(PG8_SB(0, 0), cB, voffB); PG8_STAGE(PG8_SB(0, 1), cB + hstep, voffB); PG8_STAGE(PG8_SA(0, 0), cA, voffA); PG8_STAGE(PG8_SA(0, 1), cA + hstep, voffA);
        if (wr == 1) PG8_BAR;
        PG8_WAIT_V(2); PG8_BAR;
        PG8_STAGE(PG8_SB(1, 0), cB + kstep, voffB); PG8_STAGE(PG8_SA(1, 0), cA + kstep, voffA); PG8_STAGE(PG8_SB(1, 1), cB + hstep + kstep, voffB);
        PG8_WAIT_V(6); PG8_BAR;
    } else {
        PG8_STAGE(PG8_SB(0, 0), cB, voffB); PG8_STAGE(PG8_SA(0, 0), cA, voffA); PG8_STAGE(PG8_SB(0, 1), cB + hstep, voffB); PG8_STAGE(PG8_SA(0, 1), cA + hstep, voffA);
        if (wr == 1) PG8_BAR;
        PG8_WAIT_V(4); PG8_BAR;
        PG8_STAGE(PG8_SB(1, 0), cB + kstep, voffB); PG8_STAGE(PG8_SA(1, 0), cA + kstep, voffA); PG8_STAGE(PG8_SB(1, 1), cB + hstep + kstep, voffB);
        PG8_WAIT_V(6); PG8_BAR;
    }
    for (;;) {
        const bool has_next = S.next(ui + 1, nxt);
        const char* nA = has_next ? (const char*)g.A + (size_t)nxt.pm * tstep : cA; const char* nB = has_next ? (const char*)g.Bt + (size_t)nxt.pn * tstep : cB;
        for (int t = 0; t < nt; t += 2) {
            const bool last = (t == nt - 2);
            const char* a1 = cA + (size_t)(t + 1) * kstep;
            const char* a2 = last ? nA : cA + (size_t)(t + 2) * kstep; const char* b2 = last ? nB : cB + (size_t)(t + 2) * kstep;
            const char* a3 = a2 + kstep; const char* b3 = b2 + kstep;
            if (last && has_next) S.a_ready(nxt);
            if constexpr (SP2) {
            PG8_LDB(B0, 0, 0); PG8_LDB(B1, 0, 1); PG8_SCHED; PG8_LDA(At, 0, 0); PG8_STAGE(PG8_SA(1, 1), a1 + hstep, voffA);
            PG8_WAIT_V(8); PG8_WAIT_L(0); PG8_BAR; PG8_MMA(0, 0, At, B0); PG8_MMA(0, 1, At, B1); PG8_BAR; PG8_SCHED;
            PG8_LDA(At, 0, 1); PG8_STAGE(PG8_SB(0, 0), b2, voffB); PG8_STAGE(PG8_SB(0, 1), b2 + hstep, voffB); PG8_STAGE(PG8_SA(0, 0), a2, voffA);
            PG8_WAIT_V(8); PG8_WAIT_L(0); PG8_BAR; PG8_MMA(1, 0, At, B0); PG8_MMA(1, 1, At, B1); PG8_BAR; PG8_SCHED;
            PG8_LDB(B0, 1, 0); PG8_LDB(B1, 1, 1); PG8_SCHED; PG8_LDA(At, 1, 0); PG8_STAGE(PG8_SA(0, 1), a2 + hstep, voffA);
            PG8_WAIT_V(8); PG8_WAIT_L(0); PG8_BAR; PG8_MMA(0, 0, At, B0); PG8_MMA(0, 1, At, B1); PG8_BAR; PG8_SCHED;
            PG8_LDA(At, 1, 1); PG8_STAGE(PG8_SB(1, 0), b3, voffB); PG8_STAGE(PG8_SB(1, 1), b3 + hstep, voffB); PG8_STAGE(PG8_SA(1, 0), a3, voffA);
            PG8_WAIT_V(8); PG8_WAIT_L(0); PG8_BAR; PG8_MMA(1, 0, At, B0); PG8_MMA(1, 1, At, B1); PG8_BAR; PG8_SCHED;
            } else {
            PG8_LDB(B0, 0, 0); PG8_SCHED; PG8_LDA(At, 0, 0); PG8_STAGE(PG8_SA(1, 1), a1 + hstep, voffA);
            PG8_WAIT_L(8); PG8_BAR; PG8_WAIT_L(0); PG8_MMA(0, 0, At, B0); PG8_BAR; PG8_SCHED;
            PG8_LDB(B1, 0, 1); PG8_STAGE(PG8_SB(0, 0), b2, voffB);
            PG8_BAR; PG8_WAIT_L(0); PG8_MMA(0, 1, At, B1); PG8_BAR;
            PG8_LDA(At, 0, 1); PG8_STAGE(PG8_SA(0, 0), a2, voffA);
            PG8_BAR; PG8_WAIT_L(0); PG8_MMA(1, 0, At, B0); PG8_BAR; PG8_SCHED;
            PG8_STAGE(PG8_SB(0, 1), b2 + hstep, voffB);
            PG8_WAIT_V(6); PG8_BAR; PG8_MMA(1, 1, At, B1); PG8_BAR;
            PG8_LDB(B0, 1, 0); PG8_SCHED; PG8_LDA(At, 1, 0); PG8_STAGE(PG8_SA(0, 1), a2 + hstep, voffA);
            PG8_WAIT_L(8); PG8_BAR; PG8_WAIT_L(0); PG8_MMA(0, 0, At, B0); PG8_BAR; PG8_SCHED;
            PG8_LDB(B1, 1, 1); PG8_STAGE(PG8_SB(1, 0), b3, voffB);
            PG8_BAR; PG8_WAIT_L(0); PG8_MMA(0, 1, At, B1); PG8_BAR;
            PG8_LDA(At, 1, 1); PG8_STAGE(PG8_SA(1, 0), a3, voffA);
            PG8_BAR; PG8_WAIT_L(0); PG8_MMA(1, 0, At, B0); PG8_BAR; PG8_SCHED;
            PG8_STAGE(PG8_SB(1, 1), b3 + hstep, voffB);
            PG8_WAIT_V(6); PG8_BAR; PG8_MMA(1, 1, At, B1); PG8_BAR;
            }
        }
        if constexpr (ALIGN_EPI) { if (wr == 0) PG8_BAR; }
        if constexpr (!Epi::AFTER_DRAIN) { E(acc, cur, wr, wc, fr, fq); S.done(cur); }
        if (!has_next) break;
#pragma unroll
        for (int a = 0; a < 2; ++a)
#pragma unroll
            for (int b = 0; b < 2; ++b)
#pragma unroll
                for (int m = 0; m < 4; ++m)
#pragma unroll
                    for (int n = 0; n < 2; ++n) acc[a][b][m][n] = (f32x4){0.f, 0.f, 0.f, 0.f};
        cur = nxt; cA = nA; cB = nB; ++ui;
        if constexpr (ALIGN_EPI) { if (wr == 1) PG8_BAR; }
    }
    PG8_WAIT_V(0);
    if constexpr (!ALIGN_EPI) { if (wr == 0) PG8_BAR; }
    PG8_BAR;
    if constexpr (Epi::AFTER_DRAIN) { E.fused(acc, cur, wr, wc, fr, fq, lds, wid, lane); S.done(cur); }
#undef PG8_SA
#undef PG8_SB
#undef PG8_STAGE
#undef PG8_LDA
#undef PG8_LDB
#undef PG8_MMA
#undef PG8_WAIT_V
#undef PG8_WAIT_L
#undef PG8_BAR
#undef PG8_SCHED
}
}

#define LAS __attribute__((address_space(3)))
typedef unsigned short bf16_t;
typedef short bf16x8 __attribute__((ext_vector_type(8)));
typedef short s16x4 __attribute__((ext_vector_type(4)));
typedef float f32x4 __attribute__((ext_vector_type(4)));
typedef float f32x2 __attribute__((ext_vector_type(2)));
typedef float f32x16 __attribute__((ext_vector_type(16)));
typedef unsigned u32x4 __attribute__((ext_vector_type(4)));
typedef unsigned u32x2 __attribute__((ext_vector_type(2)));
typedef __bf16 bf16x2_t __attribute__((ext_vector_type(2)));

constexpr int DM = 2048, NBATCH = 16, SEQ = 2048, DEPTH = 4, MTOK = NBATCH * SEQ, INC = 7168, MMEM = NBATCH * 256;
constexpr int C_NAQ = 0, C_NAK = 768, C_NAV = 1536, C_NAG = 2304, C_DLQ = 3072, C_DLK = 3840, C_DLV = 4608, C_DLG = 5376, C_MQ = 6144, C_MG = 6656;
constexpr float QSCALE = 0.08838834764831845f * 1.4426950408889634f;
constexpr float LOG2E = 1.4426950408889634f;
constexpr float NEGBIG = -1e30f, MINIT = -1e4f;
constexpr int NWAVES = 8;

constexpr size_t MiB = 1u << 20;
constexpr size_t WS_WIN = 1 * MiB, WS_WOUT = 113 * MiB, WS_WMEM = 145 * MiB, WS_MEMN = 161 * MiB, WS_MKV = 177 * MiB, WS_ROPE = 209 * MiB, WS_LSE = 210 * MiB,
                 WS_OP = 212 * MiB, WS_HY = 308 * MiB, WS_Z = 436 * MiB, WS_END = 884 * MiB;
constexpr int LDS_BYTES = 147456, RPB_OFF = 131072;

__device__ __forceinline__ unsigned pk2(float lo, float hi) { f32x2 v = {lo, hi}; bf16x2_t b = __builtin_convertvector(v, bf16x2_t); return __builtin_bit_cast(unsigned, b); }
__device__ __forceinline__ float bf_lo(unsigned u) { return __builtin_bit_cast(float, u << 16); }
__device__ __forceinline__ float bf_hi(unsigned u) { return __builtin_bit_cast(float, u & 0xffff0000u); }
__device__ __forceinline__ float wave_sum(float v) {
#pragma unroll
    for (int o = 1; o < 64; o <<= 1) v += __shfl_xor(v, o);
    return v;
}
__device__ __forceinline__ unsigned off_b(unsigned row, unsigned ch) { return 256u * row + 16u * (ch ^ (((row & 3u) << 2) | ((row >> 2) & 3u))); }
__device__ __forceinline__ s16x4 vtr(const LAS unsigned char* p) { return __builtin_amdgcn_ds_read_tr16_b64_v4i16((LAS s16x4*)p); }

struct Params {
    const float *x, *mem, *norm_g, *w_in, *na_rpb, *mem_norm_g, *w_mem_kv, *w_out, *final_g;
    float* out; unsigned char* ws;
};

template <int MODE>
__device__ __forceinline__ void transpose_item(const float* W, int K, int N, bf16_t* WT, LAS float* scr, int item, int lane) {
    const int nblk = N / 32, kb = item / nblk, nb = item % nblk, k0 = 64 * kb, n0 = 32 * nb;
    int src = n0 + (lane & 31); float sc = 1.f;
    if (MODE == 1) {
        if (n0 >= C_DLQ && n0 < C_DLV) { const int hb = n0 & ~127, j = (n0 & 127) + (lane & 31); src = hb + ((j & 1) ? 64 : 0) + (j >> 1); }
        if (n0 < C_NAK || (n0 >= C_DLQ && n0 < C_DLK) || (n0 >= C_MQ && n0 < C_MG)) sc = QSCALE;
    }
#pragma unroll 8
    for (int i = 0; i < 32; ++i) { const int kk = 2 * i + (lane >> 5); scr[kk * 33 + (lane & 31)] = W[(size_t)(k0 + kk) * N + src] * sc; }
    asm volatile("s_waitcnt lgkmcnt(0)" ::: "memory");
    const int c = lane & 7;
#pragma unroll
    for (int j = 0; j < 4; ++j) { const int n = (lane >> 3) + 8 * j; const LAS float* s = scr + (8 * c) * 33 + n;
        u32x4 o; o.x = pk2(s[0 * 33], s[1 * 33]); o.y = pk2(s[2 * 33], s[3 * 33]); o.z = pk2(s[4 * 33], s[5 * 33]); o.w = pk2(s[6 * 33], s[7 * 33]);
        *(u32x4*)(WT + (size_t)(n0 + n) * K + k0 + 8 * c) = o; }
    asm volatile("s_waitcnt lgkmcnt(0)" ::: "memory");
}
__device__ __forceinline__ void rms_row_bf16(const float* xrow, const float* g, bf16_t* orow, int lane) {
    const f32x4* xr = (const f32x4*)xrow + lane; const f32x4* gr = (const f32x4*)g + lane;
    f32x4 v[8]; float s = 0.f;
#pragma unroll
    for (int j = 0; j < 8; ++j) { v[j] = xr[64 * j]; s += (v[j].x * v[j].x + v[j].y * v[j].y) + (v[j].z * v[j].z + v[j].w * v[j].w); }
    const float rstd = 1.f / sqrtf(wave_sum(s) * (1.f / 2048.f) + 1e-6f);
    u32x2* o8 = (u32x2*)orow + lane;
#pragma unroll
    for (int j = 0; j < 8; ++j) { const f32x4 gg = gr[64 * j]; u32x2 w; w.x = pk2(v[j].x * rstd * gg.x, v[j].y * rstd * gg.y); w.y = pk2(v[j].z * rstd * gg.z, v[j].w * rstd * gg.w); o8[64 * j] = w; }
}

template <bool FINAL>
__device__ __forceinline__ void res_rms_row(const float* xin, const bf16_t* drow, const float* g, float* xout, bf16_t* hrow, int lane) {
    const f32x4* xr = (const f32x4*)xin + lane; const u32x2* dr = (const u32x2*)drow + lane; const f32x4* gr = (const f32x4*)g + lane;
    f32x4 v[8]; float s = 0.f;
#pragma unroll
    for (int j = 0; j < 8; ++j) { const u32x2 d = __builtin_nontemporal_load(dr + 64 * j); v[j] = __builtin_nontemporal_load(xr + 64 * j);
        v[j].x += bf_lo(d.x); v[j].y += bf_hi(d.x); v[j].z += bf_lo(d.y); v[j].w += bf_hi(d.y);
        s += (v[j].x * v[j].x + v[j].y * v[j].y) + (v[j].z * v[j].z + v[j].w * v[j].w); }
    const float rstd = 1.f / sqrtf(wave_sum(s) * (1.f / 2048.f) + 1e-6f);
    f32x4* xo = (f32x4*)xout + lane; u32x2* o8 = (u32x2*)hrow + lane;
#pragma unroll
    for (int j = 0; j < 8; ++j) { const f32x4 gg = gr[64 * j];
        if (FINAL) __builtin_nontemporal_store(v[j] * rstd * gg, xo + 64 * j);
        else { __builtin_nontemporal_store(v[j], xo + 64 * j); u32x2 w; w.x = pk2(v[j].x * rstd * gg.x, v[j].y * rstd * gg.y); w.y = pk2(v[j].z * rstd * gg.z, v[j].w * rstd * gg.w); o8[64 * j] = w; } }
}

enum { K_NA = 0, K_MEM = 1, K_DILP = 2, K_DILF = 3 };
struct AttnArgs { const bf16_t* Z; const bf16_t* MKV; bf16_t* Y; bf16_t* OP; float* LSE; const float* rpb; int layer; };

constexpr int ANS = 6, AD = 4, ARPB_OFF = ANS * 16384, AOST_OFF = ARPB_OFF + 11776;
#define ABAR() asm volatile("s_waitcnt lgkmcnt(0)\n\ts_barrier" ::: "memory")
#define AWAITV(n) asm volatile("s_waitcnt vmcnt(" #n ")" ::: "memory")
template <int PH> __device__ __forceinline__ int seg_kind(int s, int rot) { if (PH != 0) return K_DILF; int k = s + rot; k = k >= 3 ? k - 3 : k; return k == 0 ? K_NA : (k == 1 ? K_MEM : K_DILP); }
template <int PH> __device__ __forceinline__ int seg_items(int s, int rot) { const int k = seg_kind<PH>(s, rot); return k == K_NA ? 768 : (k == K_MEM ? 512 : (k == K_DILP ? 1536 : 768)); }

struct ALoader { int seg, it, t, NT, stg, mode, P0, L, voff, rot; bool done; const char* kbase; long rstride; unsigned goff, goff2; };

template <int PH> __device__ __forceinline__ void al_decode(ALoader& S, const AttnArgs& A, int w, int lane) {
    constexpr long PZ = (long)INC * 2, PM = 4096 * 2;
    const int kind = seg_kind<PH>(S.seg, S.rot); int item = S.it;
    if (kind == K_NA) {
        const int b = item / 48, rem = item % 48, hh = rem >> 3, R0 = 4 * (((rem & 7) + 3 * (item >> 8)) & 7);
        const int rs0 = min(max(R0 - 4, 0), 24), rsl = min(max(R0 - 1, 0), 24);
        S.NT = 2 * (rsl + 8 - rs0); S.mode = 3; S.rstride = PZ; S.voff = (C_NAV - C_NAK) * 2;
        S.kbase = (const char*)A.Z + ((long)b * SEQ + rs0 * 64) * PZ + (long)(C_NAK + hh * 128) * 2;
    } else if (kind == K_MEM) {
        const int b = item >> 5, rem = item & 31, hh = rem >> 3;
        S.NT = 8; S.mode = 0; S.rstride = PM; S.voff = 512 * 2;
        S.kbase = (const char*)A.MKV + (long)b * 256 * PM + (long)(A.layer * 1024 + hh * 128) * 2;
    } else {
        int cfg = 0; if (kind == K_DILP) { cfg = 1 + item / 768; item = item % 768; }
        const int b = item / 48, rem = item % 48, hh = rem >> 3, sub = rem & 7;
        const char* zb = (const char*)A.Z + (long)b * SEQ * PZ + (long)(C_DLK + hh * 128) * 2; S.voff = (C_DLV - C_DLK) * 2;
        if (cfg == 2) { S.NT = 8; S.mode = 2; S.rstride = 16 * PZ; S.kbase = zb + (long)(2 * sub) * PZ; }
        else { const int dil = cfg ? 4 : 1; int res = 0, m = sub; if (cfg == 1) { res = sub >> 1; m = sub & 1; }
            S.NT = 12; S.mode = 1; S.P0 = 256 * m; S.L = 2048 / dil; S.rstride = dil * PZ; S.kbase = zb + (long)res * PZ; }
    }
    S.goff = (unsigned)(4 * w + (lane >> 4)) * (unsigned)S.rstride + (unsigned)(((lane & 15) ^ (((lane >> 4) << 2) | (w & 3))) * 16);
    if (S.mode == 3) {
        S.goff = (unsigned)(8 * w + (lane >> 4)) * (unsigned)PZ + (unsigned)(((lane & 15) ^ (((lane >> 4) << 2) | ((2 * w) & 3))) * 16);
        S.goff2 = (unsigned)(8 * w + 4 + (lane >> 4)) * (unsigned)PZ + (unsigned)(((lane & 15) ^ (((lane >> 4) << 2) | ((2 * w + 1) & 3))) * 16); }
}
template <int PH> __device__ __forceinline__ bool al_issue(ALoader& S, LAS unsigned char* lds, const AttnArgs& A, int vcu, int w, int lane) {
    constexpr long PZ = (long)INC * 2; constexpr int NSEG = PH == 0 ? 3 : 1;
    if (S.done) return false;
    const char* p;
    if (S.mode == 0 || S.mode == 3) p = S.kbase + (long)S.t * 32 * S.rstride;
    else if (S.mode == 2) p = S.kbase + (long)(32 * (S.t & 3)) * S.rstride + (long)(S.t >> 2) * PZ;
    else { const int pos = min(max(S.P0 - 64 + 32 * S.t, 0), S.L - 32); p = S.kbase + (long)pos * S.rstride; }
    if (S.mode == 3) {
        p = S.kbase + (long)(S.t >> 1) * 64 * PZ + ((S.t & 1) ? S.voff : 0);
        LAS unsigned char* d = lds + S.stg * 16384 + w * 2048;
        __builtin_amdgcn_global_load_lds((const unsigned*)(p + S.goff), (LAS unsigned*)d, 16, 0, 0);
        __builtin_amdgcn_global_load_lds((const unsigned*)(p + S.goff2), (LAS unsigned*)(d + 1024), 16, 0, 0);
    } else {
    p += S.goff;
    LAS unsigned char* d = lds + S.stg * 16384 + w * 1024;
    __builtin_amdgcn_global_load_lds((const unsigned*)p, (LAS unsigned*)d, 16, 0, 0);
    __builtin_amdgcn_global_load_lds((const unsigned*)(p + S.voff), (LAS unsigned*)(d + 8192), 16, 0, 0);
    }
    S.stg = (S.stg + 1 == ANS) ? 0 : S.stg + 1;
    if (++S.t == S.NT) { S.t = 0; S.it += gridDim.x;
        if (S.it >= seg_items<PH>(S.seg, S.rot)) { ++S.seg; S.it = vcu; if (S.seg >= NSEG) S.done = true; }
        if (!S.done) al_decode<PH>(S, A, w, lane); }
    return true;
}

template <int PH> __device__ __forceinline__ void q_issue(bf16x8 (&qf)[8], const AttnArgs& A, int seg, int rot, int item, int w, int lane) {
    constexpr long PZ = (long)INC * 2;
    const int kind = seg_kind<PH>(seg, rot), r = lane & 31, h = lane >> 5; long tokq; int qcol;
    if (kind == K_NA) { const int b = item / 48, rem = item % 48, hh = rem >> 3, R0 = 4 * (((rem & 7) + 3 * (item >> 8)) & 7); tokq = (long)b * SEQ + (R0 + 2 * (w & 1) + (r >> 4)) * 64 + 16 * (w >> 1) + (r & 15); qcol = C_NAQ + hh * 128; }
    else if (kind == K_MEM) { const int b = item >> 5, rem = item & 31, hh = rem >> 3, qb = rem & 7; tokq = (long)b * SEQ + qb * 256 + 32 * w + r; qcol = C_MQ + hh * 128; }
    else { int cfg = 0, it = item; if (kind == K_DILP) { cfg = 1 + it / 768; it = it % 768; }
        const int b = it / 48, rem = it % 48, hh = rem >> 3, sub = rem & 7; qcol = C_DLQ + hh * 128;
        if (cfg == 2) tokq = (long)b * SEQ + (32 * (w & 3) + r) * 16 + 2 * sub + (w >> 2);
        else { const int dil = cfg ? 4 : 1; int res = 0, m = sub; if (cfg == 1) { res = sub >> 1; m = sub & 1; } tokq = (long)b * SEQ + (long)(256 * m + 32 * w + r) * dil + res; } }
    const char* qrow = (const char*)A.Z + tokq * PZ + (long)qcol * 2;
#pragma unroll
    for (int s = 0; s < 8; ++s) qf[s] = *(const bf16x8*)(qrow + (16 * s + 8 * h) * 2);
}

template <int PH, int KIND>
__device__ __forceinline__ void attn_item(LAS unsigned char* lds, const AttnArgs& A, ALoader& LS, int& cstg, bf16x8 (&qf)[8], int item, int nseg, int nitem, int vcu, int lane, int w) {
    constexpr long PZ = (long)INC * 2;
    const int r = lane & 31, h = lane >> 5;
    long tokq, tok0w; int qcol, gcol, ycol, hh, NT, qstr = 1;
    int cfg = 0, na_R = 0, na_rs0 = 0, na_rsw = 0, na_rsw_hi = 0, na_ks = 0, dl_P0 = 0, dl_L = 0;
    if (KIND == K_NA) {
        const int b = item / 48, rem = item % 48; hh = rem >> 3; const int R0 = 4 * (((rem & 7) + 3 * (item >> 8)) & 7);
        na_rs0 = min(max(R0 - 4, 0), 24); const int rsl = min(max(R0 - 1, 0), 24); NT = rsl + 8 - na_rs0;
        na_R = R0 + 2 * (w & 1); na_rsw = min(max(na_R - 4, 0), 24); na_rsw_hi = min(max(na_R - 3, 0), 24) + 8; na_ks = min(max(16 * (w >> 1) - 8, 0), 32);
        tok0w = (long)b * SEQ + na_R * 64 + 16 * (w >> 1); tokq = tok0w + (r >> 4) * 64 + (r & 15); qcol = C_NAQ + hh * 128; gcol = C_NAG + hh * 128; ycol = hh * 128;
    } else if (KIND == K_MEM) {
        const int b = item >> 5, rem = item & 31; hh = rem >> 3; const int qb = rem & 7; NT = 8;
        tok0w = (long)b * SEQ + qb * 256 + 32 * w; tokq = tok0w + r; qcol = C_MQ + hh * 128; gcol = C_MG + hh * 128; ycol = 1536 + hh * 128;
    } else {
        int it = item;
        if (KIND == K_DILP) { cfg = 1 + it / 768; it = it % 768; }
        const int b = it / 48, rem = it % 48; hh = rem >> 3; const int sub = rem & 7;
        qcol = C_DLQ + hh * 128; gcol = C_DLG + hh * 128; ycol = 768 + hh * 128;
        if (cfg == 2) {
            NT = 8; qstr = 16; tok0w = (long)b * SEQ + (32 * (w & 3)) * 16 + 2 * sub + (w >> 2); tokq = tok0w + r * 16;
        } else {
            const int dil = cfg ? 4 : 1; int res = 0, m = sub; if (cfg == 1) { res = sub >> 1; m = sub & 1; }
            dl_P0 = 256 * m; dl_L = 2048 / dil; NT = 12;
            qstr = dil; tok0w = (long)b * SEQ + (long)(dl_P0 + 32 * w) * dil + res; tokq = tok0w + (long)r * dil;
        }
    }
    auto tile_ok = [&](int t) -> bool {
        if ((KIND == K_DILP || KIND == K_DILF) && cfg != 2) { const int p = dl_P0 - 64 + 32 * t; return p >= 0 && p < dl_L; }
        return true;
    };
    auto wave_uses = [&](int t) -> bool {
        if (KIND == K_NA) { const int kr = na_rs0 + t; return kr >= na_rsw && kr < na_rsw_hi; }
        if (KIND == K_MEM) return true;
        if (cfg == 2) { const int dd = (t & 3) - (w & 3); return (t >> 2) == (w >> 2) && dd >= -2 && dd <= 2; }
        return t >= w && t <= w + 4;
    };
#pragma unroll
    for (int s = 0; s < 8; ++s) asm volatile("" : "+v"(qf[s]));
    f32x16 o[4];
#pragma unroll
    for (int c = 0; c < 4; ++c)
#pragma unroll
        for (int i = 0; i < 16; ++i) o[c][i] = 0.f;
    float mrun = MINIT, lrun = 0.f;
    const int tq = (lane & 15) >> 2, tp = lane & 3, tblk = (lane >> 4) & 1;
    const int qc = (KIND == K_NA) ? 16 * (w >> 1) + (r & 15) : 0, na_cs = min(max(qc - 8, 0), 48);
    const int na_Rq = na_R + (r >> 4), na_rsq = min(max(na_Rq - 4, 0), 24);
    const LAS float* rpbL = (const LAS float*)(lds + ARPB_OFF) + 64 + hh * 465;

#pragma unroll 1
    for (int t = 0; t < NT; ++t) {
        bool issued = al_issue<PH>(LS, lds, A, vcu, w, lane);
        if (KIND == K_NA) issued = al_issue<PH>(LS, lds, A, vcu, w, lane) && issued;
        if (tile_ok(t) && wave_uses(t)) {
            const LAS unsigned char* ldsK = lds + cstg * 16384;
            const LAS unsigned char* ldsV = (KIND == K_NA) ? lds + ((cstg + 1 == ANS) ? 0 : cstg + 1) * 16384 : ldsK + 8192;
            const int kso = (KIND == K_NA) ? na_ks : 0;
            int lr = lane; asm volatile("" : "+v"(lr));
            const int r2 = lr & 31, h2 = lr >> 5, tq2 = (lr & 15) >> 2, tp2 = lr & 3, tblk2 = (lr >> 4) & 1;
            f32x16 st;
#pragma unroll
            for (int i = 0; i < 16; ++i) st[i] = 0.f;
            bf16x8 kf[8];
#pragma unroll
            for (int s = 0; s < 8; ++s) kf[s] = *(const LAS bf16x8*)(ldsK + off_b((unsigned)(kso + r2), (unsigned)(2 * s + h2)));
            __builtin_amdgcn_sched_barrier(0);
#pragma unroll
            for (int s = 0; s < 8; ++s) st = __builtin_amdgcn_mfma_f32_32x32x16_bf16(kf[s], qf[s], st, 0, 0, 0);
            if (KIND == K_NA) {
                const int kr = na_rs0 + t, dr = kr - na_Rq + 7;
                const bool rowok = (unsigned)(kr - na_rsq) < 8u;
                const LAS float* brow = rpbL + dr * 31 + 15 - qc + na_ks + 4 * h;
                const int jrel = rowok ? na_ks + 4 * h - na_cs : 1024;
#pragma unroll
                for (int i = 0; i < 16; ++i) { const int c = (i & 3) + 8 * (i >> 2);
                    const bool ok = (unsigned)(jrel + c) < 16u;
                    const float bias = brow[c]; st[i] = ok ? st[i] + bias : NEGBIG; }
            } else if (KIND == K_DILP || KIND == K_DILF) {
                const int dt = (cfg == 2) ? ((t & 3) - (w & 3)) : (t - w - 2);
                const int d0 = 32 * dt - r;
                if (dt == -2 || dt == 2)
#pragma unroll
                for (int i = 0; i < 16; ++i) { const int j = (i & 3) + 8 * (i >> 2) + 4 * h; const int d = d0 + j;
                    const bool ok = (d >= -64) && (d <= 64); st[i] = ok ? st[i] : NEGBIG; }
            }
            float tmax = st[0];
#pragma unroll
            for (int i = 1; i < 16; ++i) tmax = fmaxf(tmax, st[i]);
            tmax = fmaxf(tmax, __shfl_xor(tmax, 32));
            const float mnew = fmaxf(mrun, tmax);
            const float alpha = __builtin_amdgcn_exp2f(mrun - mnew);
            mrun = mnew;
            float psum = 0.f;
#pragma unroll
            for (int i = 0; i < 16; ++i) { const float p = __builtin_amdgcn_exp2f(st[i] - mnew); st[i] = p; psum += p; }
            lrun = lrun * alpha + psum;
            if (__builtin_amdgcn_ballot_w64(alpha != 1.0f) != 0) {
#pragma unroll
                for (int c = 0; c < 4; ++c)
#pragma unroll
                    for (int i = 0; i < 16; ++i) o[c][i] *= alpha;
            }
            unsigned va[8]; s16x4 vv[16];
#pragma unroll
            for (int c = 0; c < 4; ++c) {
                const unsigned row0 = (unsigned)(kso + 4 * h2 + tq2), chn = (unsigned)(4 * c + 2 * tblk2 + (tp2 >> 1));
                va[2 * c] = (unsigned)(size_t)ldsV + off_b(row0, chn) + 8 * (tp2 & 1); va[2 * c + 1] = (unsigned)(size_t)ldsV + off_b(row0 + 8, chn) + 8 * (tp2 & 1);
            }
            asm volatile("ds_read_b64_tr_b16 %0, %16\n\tds_read_b64_tr_b16 %1, %17\n\tds_read_b64_tr_b16 %2, %18\n\tds_read_b64_tr_b16 %3, %19\n\t"
                         "ds_read_b64_tr_b16 %4, %20\n\tds_read_b64_tr_b16 %5, %21\n\tds_read_b64_tr_b16 %6, %22\n\tds_read_b64_tr_b16 %7, %23\n\t"
                         "ds_read_b64_tr_b16 %8, %16 offset:4096\n\tds_read_b64_tr_b16 %9, %17 offset:4096\n\tds_read_b64_tr_b16 %10, %18 offset:4096\n\tds_read_b64_tr_b16 %11, %19 offset:4096\n\t"
                         "ds_read_b64_tr_b16 %12, %20 offset:4096\n\tds_read_b64_tr_b16 %13, %21 offset:4096\n\tds_read_b64_tr_b16 %14, %22 offset:4096\n\tds_read_b64_tr_b16 %15, %23 offset:4096\n\ts_waitcnt lgkmcnt(0)"
                         : "=&v"(vv[0]), "=&v"(vv[1]), "=&v"(vv[2]), "=&v"(vv[3]), "=&v"(vv[4]), "=&v"(vv[5]), "=&v"(vv[6]), "=&v"(vv[7]),
                           "=&v"(vv[8]), "=&v"(vv[9]), "=&v"(vv[10]), "=&v"(vv[11]), "=&v"(vv[12]), "=&v"(vv[13]), "=&v"(vv[14]), "=&v"(vv[15])
                         : "v"(va[0]), "v"(va[1]), "v"(va[2]), "v"(va[3]), "v"(va[4]), "v"(va[5]), "v"(va[6]), "v"(va[7]) : "memory");
#pragma unroll
            for (int s2 = 0; s2 < 2; ++s2) {
                u32x4 pw; pw.x = pk2(st[8 * s2 + 0], st[8 * s2 + 1]); pw.y = pk2(st[8 * s2 + 2], st[8 * s2 + 3]);
                pw.z = pk2(st[8 * s2 + 4], st[8 * s2 + 5]); pw.w = pk2(st[8 * s2 + 6], st[8 * s2 + 7]);
                const bf16x8 pb = __builtin_bit_cast(bf16x8, pw);
#pragma unroll
                for (int c = 0; c < 4; ++c) {
                    const bf16x8 a = __builtin_shufflevector(vv[8 * s2 + 2 * c], vv[8 * s2 + 2 * c + 1], 0, 1, 2, 3, 4, 5, 6, 7);
                    o[c] = __builtin_amdgcn_mfma_f32_32x32x16_bf16(a, pb, o[c], 0, 0, 0);
                }
            }
        }
        if (issued) AWAITV(4); else AWAITV(0);
        ABAR();
        cstg = (cstg + 1 == ANS) ? 0 : cstg + 1;
        if (KIND == K_NA) cstg = (cstg + 1 == ANS) ? 0 : cstg + 1;
    }
    const float ltot = lrun + __shfl_xor(lrun, 32);
    const float inv = __builtin_amdgcn_rcpf(ltot);
    const float lse2 = mrun + __builtin_amdgcn_logf(ltot);
    LAS unsigned char* ost = lds + AOST_OFF + w * 4608;
    if (nseg >= 0) q_issue<PH>(qf, A, nseg, LS.rot, nitem, w, lane);
    const int ch = lane & 7;
#pragma unroll
    for (int hd = 0; hd < 2; ++hd) {
#pragma unroll
        for (int c2 = 0; c2 < 2; ++c2)
#pragma unroll
            for (int g = 0; g < 4; ++g) { const int c = 2 * hd + c2; u32x2 wv; wv.x = pk2(o[c][4 * g] * inv, o[c][4 * g + 1] * inv); wv.y = pk2(o[c][4 * g + 2] * inv, o[c][4 * g + 3] * inv);
                *(LAS u32x2*)(ost + r * 144 + (32 * c2 + 8 * g + 4 * h) * 2) = wv; }
        if (hd == 0 && (KIND == K_DILP || KIND == K_DILF)) { if (h == 0) *(LAS float*)(ost + r * 144 + 128) = lse2; }
        asm volatile("s_waitcnt lgkmcnt(0)" ::: "memory");
        u32x4 gg[4], a2[4], a3[4]; float l2[4], l3[4];
#pragma unroll
        for (int k = 0; k < 4; ++k) { const int q = (lane >> 3) + 8 * k; const long tok = tok0w + ((KIND == K_NA) ? (long)((q >> 4) * 64 + (q & 15)) : (long)q * qstr); const int dcol = 64 * hd + 8 * ch;
            if (KIND != K_DILP) gg[k] = *(const u32x4*)(A.Z + tok * INC + gcol + dcol);
            if (KIND == K_DILF) { a2[k] = *(const u32x4*)(A.OP + tok * 768 + hh * 128 + dcol); a3[k] = *(const u32x4*)(A.OP + (size_t)MTOK * 768 + tok * 768 + hh * 128 + dcol);
                l2[k] = A.LSE[tok * 6 + hh]; l3[k] = A.LSE[(size_t)MTOK * 6 + tok * 6 + hh]; } }
#pragma unroll
        for (int k = 0; k < 4; ++k) { const int q = (lane >> 3) + 8 * k; const long tok = tok0w + ((KIND == K_NA) ? (long)((q >> 4) * 64 + (q & 15)) : (long)q * qstr); const int dcol = 64 * hd + 8 * ch;
            const u32x4 ov = *(const LAS u32x4*)(ost + q * 144 + ch * 16);
            if (KIND == K_DILP) {
                *(u32x4*)(A.OP + (size_t)(cfg - 1) * ((size_t)MTOK * 768) + tok * 768 + hh * 128 + dcol) = ov;
                if (hd == 0 && ch == 0) A.LSE[(size_t)(cfg - 1) * (MTOK * 6) + tok * 6 + hh] = *(const LAS float*)(ost + q * 144 + 128);
            } else {
                float v[8] = {bf_lo(ov.x), bf_hi(ov.x), bf_lo(ov.y), bf_hi(ov.y), bf_lo(ov.z), bf_hi(ov.z), bf_lo(ov.w), bf_hi(ov.w)};
                if (KIND == K_DILF) {
                    const float l1 = *(const LAS float*)(ost + q * 144 + 128);
                    const float mx = fmaxf(l1, fmaxf(l2[k], l3[k]));
                    const float e1 = __builtin_amdgcn_exp2f(l1 - mx), e2 = __builtin_amdgcn_exp2f(l2[k] - mx), e3 = __builtin_amdgcn_exp2f(l3[k] - mx);
                    const float isum = __builtin_amdgcn_rcpf(e1 + e2 + e3); const float wa = e1 * isum, wb = e2 * isum, wc = e3 * isum;
                    v[0] = wa * v[0] + wb * bf_lo(a2[k].x) + wc * bf_lo(a3[k].x); v[1] = wa * v[1] + wb * bf_hi(a2[k].x) + wc * bf_hi(a3[k].x);
                    v[2] = wa * v[2] + wb * bf_lo(a2[k].y) + wc * bf_lo(a3[k].y); v[3] = wa * v[3] + wb * bf_hi(a2[k].y) + wc * bf_hi(a3[k].y);
                    v[4] = wa * v[4] + wb * bf_lo(a2[k].z) + wc * bf_lo(a3[k].z); v[5] = wa * v[5] + wb * bf_hi(a2[k].z) + wc * bf_hi(a3[k].z);
                    v[6] = wa * v[6] + wb * bf_lo(a2[k].w) + wc * bf_lo(a3[k].w); v[7] = wa * v[7] + wb * bf_hi(a2[k].w) + wc * bf_hi(a3[k].w);
                }
                const float g8[8] = {bf_lo(gg[k].x), bf_hi(gg[k].x), bf_lo(gg[k].y), bf_hi(gg[k].y), bf_lo(gg[k].z), bf_hi(gg[k].z), bf_lo(gg[k].w), bf_hi(gg[k].w)};
#pragma unroll
                for (int e = 0; e < 8; ++e) v[e] *= g8[e] * __builtin_amdgcn_rcpf(1.f + __builtin_amdgcn_exp2f(-LOG2E * g8[e]));
                u32x4 yv; yv.x = pk2(v[0], v[1]); yv.y = pk2(v[2], v[3]); yv.z = pk2(v[4], v[5]); yv.w = pk2(v[6], v[7]);
                *(u32x4*)(A.Y + tok * 2048 + ycol + dcol) = yv;
            }
        }
    }
}

#define RLX_AGENT __ATOMIC_RELAXED, __HIP_MEMORY_SCOPE_AGENT
#define XB_TMO      128
#define XB_XCNT(j)  (256  + 64 * (j))
#define XB_XSUB(j)  (1280 + 64 * (j))
#define XB_XGEN(j)  (2304 + 64 * (j))
#define XB_TOP      3328
#define XB_TOPGEN   3392
#define XCD_BAR_WORDS 3456
#define XB_SPIN_CAP (1u << 18)

__device__ __forceinline__ unsigned xb_ld(unsigned* p)              { return __hip_atomic_load(p, __ATOMIC_RELAXED, __HIP_MEMORY_SCOPE_AGENT); }
__device__ __forceinline__ unsigned xb_add(unsigned* p, unsigned v) { return __hip_atomic_fetch_add(p, v, __ATOMIC_RELAXED, __HIP_MEMORY_SCOPE_AGENT); }
__device__ __forceinline__ unsigned xb_xcc_id() { return (unsigned)__builtin_amdgcn_s_getreg((3 << 11) | 20) & 0xFu; }
#define XB_SPIN(cond, bar) do { unsigned _sp = 0; while (cond) { __builtin_amdgcn_s_sleep(1); \
    if ((++_sp & 255u) == 0u) { if (xb_ld(&(bar)[XB_TMO])) break; if (_sp > XB_SPIN_CAP) { atomicAdd(&(bar)[XB_TMO], 1u); break; } } } } while (0)

struct XcdBarrier {
    unsigned* bar; unsigned x;
    volatile LAS unsigned* st;
};

__device__ __forceinline__ XcdBarrier xcd_barrier_post(unsigned* bar, volatile LAS unsigned* st) {
    XcdBarrier b; b.bar = bar; b.x = xb_xcc_id(); b.st = st;
    if (threadIdx.x == 0) (void)xb_add(&bar[XB_XCNT(b.x)], 1u);
    return b;
}
__device__ __forceinline__ void xcd_barrier_complete(unsigned* bar, unsigned x, unsigned& nloc, unsigned& nx) {
    const unsigned G = gridDim.x * gridDim.y * gridDim.z;
    unsigned sum, cnt, mine, sp = 0u;
    for (;;) {
        sum = 0u; cnt = 0u; mine = 0u;
#pragma unroll
        for (unsigned j = 0; j < 16; ++j) { const unsigned c = xb_ld(&bar[XB_XCNT(j)]); sum += c; cnt += (c > 0u) ? 1u : 0u; mine = (j == x) ? c : mine; }
        if (sum == G) break;
        __builtin_amdgcn_s_sleep(1);
        if ((++sp & 255u) == 0u) { if (xb_ld(&bar[XB_TMO])) break; if (sp > XB_SPIN_CAP) { atomicAdd(&bar[XB_TMO], 1u); break; } }
    }
    nloc = mine > 0u ? mine : 1u; nx = cnt > 0u ? cnt : 1u;
}

__device__ __forceinline__ void xcd_barrier(const XcdBarrier& b) {
    asm volatile("s_waitcnt vmcnt(0)" ::: "memory");
    __syncthreads();
    if (threadIdx.x == 0) {
        unsigned* bar = b.bar;
        __builtin_amdgcn_s_waitcnt(0);
        unsigned nloc = b.st[0], nx = b.st[1];
        if (nloc == 0u) { xcd_barrier_complete(bar, b.x, nloc, nx); b.st[0] = nloc; b.st[1] = nx; }
        const unsigned old = xb_add(&bar[XB_XSUB(b.x)], 1u);
        const unsigned gen = old / nloc;
        if (old + 1u == (gen + 1u) * nloc) {
            __builtin_amdgcn_fence(__ATOMIC_RELEASE, "agent");
            asm volatile("s_waitcnt vmcnt(0)" ::: "memory");
            const unsigned og = xb_add(&bar[XB_TOP], 1u);
            const unsigned tg = og / nx;
            if (og + 1u == (tg + 1u) * nx) xb_add(&bar[XB_TOPGEN], 1u);
            else XB_SPIN(xb_ld(&bar[XB_TOPGEN]) == tg, bar);
            __builtin_amdgcn_fence(__ATOMIC_ACQUIRE, "agent");
            xb_add(&bar[XB_XGEN(b.x)], 1u);
            asm volatile("s_waitcnt vmcnt(0)" ::: "memory");
        } else {
            XB_SPIN(xb_ld(&bar[XB_XGEN(b.x)]) == gen, bar);
            __builtin_amdgcn_fence(__ATOMIC_ACQUIRE, "agent");
            asm volatile("s_waitcnt vmcnt(0)" ::: "memory");
        }
    }
    __syncthreads();
}

template <int PH>
__device__ __forceinline__ void attn_phase(LAS unsigned char* lds, const AttnArgs& A, int tid, int wid) {
    asm volatile("" : "+v"(tid));
    const int lane = tid & 63;
    const int vcu = (gridDim.x % 8 == 0) ? (blockIdx.x % 8) * (gridDim.x / 8) + blockIdx.x / 8 : blockIdx.x;
    if (PH == 0) { LAS float* rp = (LAS float*)(lds + ARPB_OFF) + 64; for (int e = tid; e < 6 * 465; e += NWAVES * 64) rp[e] = A.rpb[e] * LOG2E; }
    const int rot = PH == 0 ? (vcu >> 3) % 3 : 0;
    ALoader LS; LS.rot = rot; LS.seg = 0; LS.it = vcu; LS.t = 0; LS.stg = 0; LS.done = false; LS.P0 = 0; LS.L = 32; LS.mode = 0;
    al_decode<PH>(LS, A, wid, lane);
#pragma unroll
    for (int i = 0; i < AD; ++i) (void)al_issue<PH>(LS, lds, A, vcu, wid, lane);
    AWAITV(4); ABAR();
    int cstg = 0;
    constexpr int NSEG = PH == 0 ? 3 : 1;
    bf16x8 qf[8];
    q_issue<PH>(qf, A, 0, rot, vcu, wid, lane);
    int seg = 0, it = vcu;
#pragma unroll 1
    while (seg < NSEG) {
        int nseg = seg, nit = it + (int)gridDim.x;
        if (nit >= seg_items<PH>(seg, rot)) { nseg = seg + 1; nit = vcu; if (nseg >= NSEG) nseg = -1; }
        if (PH == 0) {
            const int kind = seg_kind<PH>(seg, rot);
            if (kind == K_NA) attn_item<PH, K_NA>(lds, A, LS, cstg, qf, it, nseg, nit, vcu, lane, wid);
            else if (kind == K_MEM) attn_item<PH, K_MEM>(lds, A, LS, cstg, qf, it, nseg, nit, vcu, lane, wid);
            else attn_item<PH, K_DILP>(lds, A, LS, cstg, qf, it, nseg, nit, vcu, lane, wid);
        } else attn_item<PH, K_DILF>(lds, A, LS, cstg, qf, it, nseg, nit, vcu, lane, wid);
        if (nseg < 0) break;
        seg = nseg; it = nit;
    }
    AWAITV(0); ABAR();
}

__global__ void __launch_bounds__(NWAVES * 64, 2) fwd_kernel(Params P) {
    extern __shared__ __attribute__((aligned(16))) unsigned char lds_raw[];
    LAS unsigned char* lds = (LAS unsigned char*)lds_raw;
    cg::grid_group grid = cg::this_grid();
    { volatile LAS unsigned* MISC0 = (volatile LAS unsigned*)(lds + LDS_BYTES - 64); if (threadIdx.x < 16) MISC0[threadIdx.x] = 0u; }
    __syncthreads();
    (void)xcd_barrier_post((unsigned*)P.ws + 4096, (volatile LAS unsigned*)(lds + LDS_BYTES - 64));
    grid.sync();
    const int wid0 = __builtin_amdgcn_readfirstlane((int)threadIdx.x >> 6);
    const int G = gridDim.x, NGW = G * NWAVES;
#define PHASE_BEGIN { unsigned char* ws = P.ws; asm volatile("" : "+s"(ws)); bf16_t* WinT = (bf16_t*)(ws + WS_WIN); bf16_t* WoutT = (bf16_t*)(ws + WS_WOUT); bf16_t* WmemT = (bf16_t*)(ws + WS_WMEM); bf16_t* MEMN = (bf16_t*)(ws + WS_MEMN); bf16_t* MKV = (bf16_t*)(ws + WS_MKV); float* ropeC = (float*)(ws + WS_ROPE); float* ropeS = ropeC + 2048 * 64; float* LSE = (float*)(ws + WS_LSE); bf16_t* OP = (bf16_t*)(ws + WS_OP); bf16_t* HB = (bf16_t*)(ws + WS_HY); bf16_t* YB = HB; bf16_t* ZB = (bf16_t*)(ws + WS_Z); (void)WinT; (void)WoutT; (void)WmemT; (void)MEMN; (void)MKV; (void)ropeS; (void)LSE; (void)OP; (void)YB; (void)ZB; int lane; asm volatile("v_mbcnt_lo_u32_b32 %0, -1, 0\n\tv_mbcnt_hi_u32_b32 %0, -1, %0" : "=&v"(lane));     const int wid = wid0, tidp = wid0 * 64 + lane, gw = blockIdx.x * NWAVES + wid; (void)gw;
#define PHASE_END(dosync) if (dosync) { XcdBarrier xb_; xb_.bar = (unsigned*)P.ws + 4096; xb_.x = xb_xcc_id(); xb_.st = (volatile LAS unsigned*)(lds + LDS_BYTES - 64); xcd_barrier(xb_); } }

    PHASE_BEGIN
      {
        LAS float* scr = (LAS float*)(lds + wid * 16384);
        constexpr int I_IN = (DM / 64) * (INC / 32), I_OUT = (DM / 64) * (DM / 32), I_MEM = (DM / 64) * (1024 / 32);
        constexpr int NITEMS = DEPTH * (I_IN + I_OUT + I_MEM);
        for (int it = gw; it < NITEMS; it += NGW) {
            int rr = it;
            if (rr < DEPTH * I_IN) { const int l = rr / I_IN; transpose_item<1>(P.w_in + (size_t)l * DM * INC, DM, INC, WinT + (size_t)l * INC * DM, scr, rr % I_IN, lane); continue; } rr -= DEPTH * I_IN;
            if (rr < DEPTH * I_OUT) { const int l = rr / I_OUT; transpose_item<0>(P.w_out + (size_t)l * DM * DM, DM, DM, WoutT + (size_t)l * DM * DM, scr, rr % I_OUT, lane); continue; } rr -= DEPTH * I_OUT;
            { const int l = rr / I_MEM; transpose_item<0>(P.w_mem_kv + (size_t)l * DM * 1024, DM, 1024, WmemT + (size_t)l * 1024 * DM, scr, rr % I_MEM, lane); }
        }
        for (int m = gw; m < MMEM; m += NGW) rms_row_bf16(P.mem + (size_t)m * DM, P.mem_norm_g, MEMN + (size_t)m * DM, lane);
        for (int m = gw; m < MTOK; m += NGW) rms_row_bf16(P.x + (size_t)m * DM, P.norm_g, HB + (size_t)m * DM, lane);
        for (int e = blockIdx.x * 512 + tidp; e < 2048 * 64; e += G * 512) { const int pos = e >> 6, i = e & 63;
            const float inv = exp2f(-(float)i * (13.287712379549449f / 64.f));
            const float ang = (float)pos * inv; float sn, cs; sincosf(ang, &sn, &cs); ropeC[e] = cs; ropeS[e] = sn; }
      }
    PHASE_END(true)

    PHASE_BEGIN
        pg8::Gemm g{MEMN, WmemT, MMEM, 4096, DM}; pg8::StaticOrder S; S.init(MMEM, 4096, G, (int)blockIdx.x);
        pg8::EpiBf16 E{MKV, 4096};
        pg8::gemm_phase<pg8::EpiBf16, pg8::StaticOrder, true, true>(lds, g, S, E, tidp);
    PHASE_END(false)

#pragma unroll 1
    for (int l = 0; l < DEPTH; ++l) {
        PHASE_BEGIN
            pg8::Gemm g{HB, WinT + (size_t)l * INC * DM, MTOK, INC, DM}; pg8::StaticOrder S; S.init(MTOK, INC, G, (int)blockIdx.x);
            pg8::EpiZ E{ZB, ropeC, ropeS};
            pg8::gemm_phase<pg8::EpiZ, pg8::StaticOrder, true, true>(lds, g, S, E, tidp);
        PHASE_END(true)
        PHASE_BEGIN
            AttnArgs A{ZB, MKV, YB, OP, LSE, P.na_rpb + (size_t)l * 6 * 465, l};
            attn_phase<0>(lds, A, tidp, wid);
        PHASE_END(true)
        PHASE_BEGIN
            AttnArgs A{ZB, MKV, YB, OP, LSE, P.na_rpb + (size_t)l * 6 * 465, l};
            attn_phase<1>(lds, A, tidp, wid);
            __syncthreads();
        PHASE_END(true)
        PHASE_BEGIN
            pg8::Gemm g{YB, WoutT + (size_t)l * DM * DM, MTOK, DM, DM}; pg8::StaticOrder S; S.init(MTOK, DM, G, (int)blockIdx.x);
            pg8::EpiBf16 E{ZB, DM};
            pg8::gemm_phase<pg8::EpiBf16, pg8::StaticOrder, true, true>(lds, g, S, E, tidp);
        PHASE_END(true)
        PHASE_BEGIN
            const float* xin = l == 0 ? P.x : (const float*)P.out;
            if (l + 1 < DEPTH) { for (int m = gw; m < MTOK; m += NGW) res_rms_row<false>(xin + (size_t)m * DM, ZB + (size_t)m * DM, P.norm_g + (size_t)(l + 1) * DM, P.out + (size_t)m * DM, HB + (size_t)m * DM, lane); }
            else { for (int m = gw; m < MTOK; m += NGW) res_rms_row<true>(xin + (size_t)m * DM, ZB + (size_t)m * DM, P.final_g, P.out + (size_t)m * DM, HB, lane); }
        PHASE_END(l + 1 < DEPTH)
    }
}

constexpr int N_PHASES = 2 + DEPTH * 5;

extern "C" void kernel_launch(void* const* d_in, const int* in_sizes, int n_in, void* d_out, int out_size, void* d_ws, size_t ws_size, hipStream_t stream) {
    static int grid = 0;
    if (grid == 0) {
        if (n_in != 9 || out_size != MTOK * DM || ws_size < WS_END) { fprintf(stderr, "kernel_launch: unexpected shapes (n_in %d out %d ws %zu)\n", n_in, out_size, ws_size); grid = -1; return; }
        int dev = 0, cus = 0, per_cu = 0;
        (void)hipGetDevice(&dev); (void)hipDeviceGetAttribute(&cus, hipDeviceAttributeMultiprocessorCount, dev);
        (void)hipFuncSetAttribute((const void*)fwd_kernel, hipFuncAttributeMaxDynamicSharedMemorySize, LDS_BYTES);
        (void)hipOccupancyMaxActiveBlocksPerMultiprocessor(&per_cu, (const void*)fwd_kernel, NWAVES * 64, LDS_BYTES);
        if (per_cu < 1) { fprintf(stderr, "kernel_launch: occupancy query says %d blocks/CU\n", per_cu); per_cu = 1; }
        (void)hipGetLastError();
        grid = cus * per_cu;
    }
    if (grid < 0) return;
    Params p{};
    p.x = (const float*)d_in[0]; p.mem = (const float*)d_in[1]; p.norm_g = (const float*)d_in[2]; p.w_in = (const float*)d_in[3]; p.na_rpb = (const float*)d_in[4];
    p.mem_norm_g = (const float*)d_in[5]; p.w_mem_kv = (const float*)d_in[6]; p.w_out = (const float*)d_in[7]; p.final_g = (const float*)d_in[8];
    p.out = (float*)d_out; p.ws = (unsigned char*)d_ws;
    (void)hipMemsetAsync(d_ws, 0, 65536, stream);
    void* args[] = {&p};
    hipError_t e = hipLaunchCooperativeKernel((const void*)fwd_kernel, dim3(grid), dim3(NWAVES * 64), args, LDS_BYTES, stream);
    if (e != hipSuccess) fprintf(stderr, "cooperative launch failed: %s (grid %d)\n", hipGetErrorString(e), grid);
}
```

```cpp
#include <hip/hip_runtime.h>
#include <hip/hip_cooperative_groups.h>
#include <cstdio>
#include <cstdint>
namespace cg = cooperative_groups;
namespace pg8 {
#define PG8_LAS __attribute__((address_space(3)))
typedef unsigned short bf16_t;
typedef short bf16x8 __attribute__((ext_vector_type(8)));
typedef float f32x4 __attribute__((ext_vector_type(4)));
typedef unsigned u32x4 __attribute__((ext_vector_type(4)));
constexpr int BM = 256, BK = 64, HALF = 128, HTB = HALF * BK * 2  , STAGE_BYTES = 8 * HTB, NXCD = 8, WGM = 8;

__host__ __device__ __forceinline__ int lds_byte(int r, int c) { const int st = (r >> 4) * 2 + (c >> 5), rr = r & 15, cc = c & 31, ob = rr * 64 + cc * 2; return st * 1024 + (ob ^ (((ob >> 9) & 1) << 5)); }
__host__ __device__ __forceinline__ void stage_rc(int b, int& R, int& C) { const int st = b / 1024, sb = b % 1024, swz = sb ^ (((sb >> 9) & 1) << 5); R = (st >> 1) * 16 + swz / 64; C = (st & 1) * 32 + (swz % 64) / 2; }
__host__ __device__ __forceinline__ int perm32(int rho) { const int n = rho >> 4, i = rho & 15; return 8 * (i >> 2) + 4 * n + (i & 3); }

struct Unit { int pm, pn; };
struct Gemm { const bf16_t* A; const bf16_t* Bt; int M, N, K; };

struct StaticOrder {
    int nM, nN, nwg, G, c;
    __host__ __device__ void init(int M, int N, int G_, int c_) { nM = M / BM; nN = N / BM; nwg = nM * nN; G = G_; c = c_; }
    __host__ __device__ bool next(int i, Unit& u) const {
        const long L = (long)i * G + c; if (L >= nwg) return false;
        int wgid = (int)L; { const int q = nwg / NXCD, r = nwg % NXCD, xcd = wgid % NXCD, off = wgid / NXCD; wgid = (xcd < r ? xcd * (q + 1) : r * (q + 1) + (xcd - r) * q) + off; }
        const int nig = WGM * nN, gid = wgid / nig, fm = gid * WGM, gsz = (nM - fm) < WGM ? (nM - fm) : WGM;
        u.pm = fm + ((wgid % nig) % gsz); u.pn = (wgid % nig) / gsz; return true;
    }
    __device__ __forceinline__ void a_ready(const Unit&) const {}
    __device__ __forceinline__ void done(const Unit&) const {}
};

__device__ __forceinline__ unsigned cvt_pk_bf16(float lo, float hi) { unsigned r; asm volatile("v_cvt_pk_bf16_f32 %0, %1, %2" : "=v"(r) : "v"(lo), "v"(hi)); return r; }

struct EpiBf16 {
    static constexpr bool PERM = true, AFTER_DRAIN = false;
    bf16_t* O; int ldc;
    __device__ __forceinline__ void operator()(const f32x4 (&acc)[2][2][4][2], const Unit& u, int wr, int wc, int fr, int fq) const {
        const int row0 = u.pm * BM + wr * 64 + fr; const int col0 = u.pn * BM + wc * 32 + 8 * fq;
#pragma unroll
        for (int ai = 0; ai < 2; ++ai)
#pragma unroll
            for (int m = 0; m < 4; ++m) { bf16_t* rowp = O + (size_t)(row0 + ai * HALF + m * 16) * ldc + col0;
#pragma unroll
                for (int bj = 0; bj < 2; ++bj) { const f32x4 v0 = acc[ai][bj][m][0], v1 = acc[ai][bj][m][1];
                    u32x4 w; w.x = cvt_pk_bf16(v0[0], v0[1]); w.y = cvt_pk_bf16(v0[2], v0[3]); w.z = cvt_pk_bf16(v1[0], v1[1]); w.w = cvt_pk_bf16(v1[2], v1[3]);
                    *(u32x4*)(rowp + bj * HALF) = w; } }
    }
};

struct EpiZ {
    static constexpr bool PERM = true, AFTER_DRAIN = false;
    bf16_t* Z; const float* ropeC; const float* ropeS;
    __device__ __forceinline__ void operator()(const f32x4 (&acc)[2][2][4][2], const Unit& u, int wr, int wc, int fr, int fq) const {
        const int row0 = u.pm * BM + wr * 64 + fr; const int col0 = u.pn * BM + wc * 32 + 8 * fq;
        const bool rope = (u.pn >= 12 && u.pn < 18);
        const int i0 = wc * 16 + 4 * fq;
#pragma unroll
        for (int ai = 0; ai < 2; ++ai)
#pragma unroll
            for (int m = 0; m < 4; ++m) { const int row = row0 + ai * HALF + m * 16; bf16_t* rowp = Z + (size_t)row * 7168 + col0;
                f32x4 c4 = (f32x4){1.f, 1.f, 1.f, 1.f}, s4 = (f32x4){0.f, 0.f, 0.f, 0.f};
                if (rope) { const int pos = row & 2047; c4 = *(const f32x4*)(ropeC + pos * 64 + i0); s4 = *(const f32x4*)(ropeS + pos * 64 + i0); }
#pragma unroll
                for (int bj = 0; bj < 2; ++bj) { const f32x4 v0 = acc[ai][bj][m][0], v1 = acc[ai][bj][m][1];
                    const float a0 = v0[0] * c4[0] - v0[1] * s4[0], b0 = v0[1] * c4[0] + v0[0] * s4[0];
                    const float a1 = v0[2] * c4[1] - v0[3] * s4[1], b1 = v0[3] * c4[1] + v0[2] * s4[1];
                    const float a2 = v1[0] * c4[2] - v1[1] * s4[2], b2 = v1[1] * c4[2] + v1[0] * s4[2];
                    const float a3 = v1[2] * c4[3] - v1[3] * s4[3], b3 = v1[3] * c4[3] + v1[2] * s4[3];
                    u32x4 w; w.x = cvt_pk_bf16(a0, b0); w.y = cvt_pk_bf16(a1, b1); w.z = cvt_pk_bf16(a2, b2); w.w = cvt_pk_bf16(a3, b3);
                    *(u32x4*)(rowp + bj * HALF) = w; }
                __builtin_amdgcn_sched_barrier(0); }
    }
};


template <class Epi, class Sched, bool ALIGN_EPI = false, bool SP2 = false>
__device__ __forceinline__ void gemm_phase(PG8_LAS unsigned char* lds, const Gemm g, const Sched& S, const Epi& E, int tid_in) {
    int tid_o = tid_in; asm volatile("" : "+v"(tid_o));
    const int tid = tid_o, wid = __builtin_amdgcn_readfirstlane(tid >> 6), lane = tid & 63, wr = wid >> 2, wc = wid & 3, fr = lane & 15, fq = lane >> 4;
    const int K = g.K, nt = K / BK;
    unsigned voffA[2], voffB[2];
#pragma unroll
    for (int i = 0; i < 2; ++i) { int R, C; stage_rc(tid * 16 + i * 8192, R, C); const int Rb = Epi::PERM ? ((R & ~31) + perm32(R & 31)) : R;
        voffA[i] = (unsigned)(R * K + C) * 2u; voffB[i] = (unsigned)(Rb * K + C) * 2u; }
    const size_t kstep = (size_t)(BK * 2);
    const size_t hstep = (size_t)HALF * K * 2;
    const size_t tstep = 2 * hstep;
    const unsigned ldsw = (unsigned)wid * 1024u;
    const int aoff = lds_byte(wr * 64 + fr, fq * 8), boff = lds_byte(wc * 32 + fr, fq * 8);
#define PG8_SA(b, h) (((b) * 2 + (h)) * HTB)
#define PG8_SB(b, h) ((4 + (b) * 2 + (h)) * HTB)
#define PG8_STAGE(bufoff, gbase, voff) do { _Pragma("unroll") for (int _i = 0; _i < 2; ++_i) \
        __builtin_amdgcn_global_load_lds((const unsigned*)((const char*)(gbase) + (voff)[_i]), (PG8_LAS unsigned*)(lds + (bufoff) + ldsw + _i * 8192), 16, 0, 0); } while (0)
#define PG8_LDA(dst, b, h) do { _Pragma("unroll") for (int m = 0; m < 4; ++m) _Pragma("unroll") for (int k = 0; k < 2; ++k) dst[m][k] = *(const PG8_LAS bf16x8*)(lds + PG8_SA(b, h) + aoff + m * 2048 + k * 1024); } while (0)
#define PG8_LDB(dst, b, h) do { _Pragma("unroll") for (int n = 0; n < 2; ++n) _Pragma("unroll") for (int k = 0; k < 2; ++k) dst[n][k] = *(const PG8_LAS bf16x8*)(lds + PG8_SB(b, h) + boff + n * 2048 + k * 1024); } while (0)
#define PG8_MMA(ai, bj, At, Bt) do { __builtin_amdgcn_s_setprio(1); _Pragma("unroll") for (int m = 0; m < 4; ++m) _Pragma("unroll") for (int n = 0; n < 2; ++n) _Pragma("unroll") for (int k = 0; k < 2; ++k) \
        acc[ai][bj][m][n] = __builtin_amdgcn_mfma_f32_16x16x32_bf16(Bt[n][k], At[m][k], acc[ai][bj][m][n], 0, 0, 0); __builtin_amdgcn_s_setprio(0); } while (0)
#define PG8_WAIT_V(n) asm volatile("s_waitcnt vmcnt(" #n ")" ::: "memory")
#define PG8_WAIT_L(n) asm volatile("s_waitcnt lgkmcnt(" #n ")" ::: "memory")
#define PG8_BAR __builtin_amdgcn_s_barrier()
#define PG8_SCHED __builtin_amdgcn_sched_barrier(0)
    Unit cur, nxt; int ui = 0;
    if (!S.next(0, cur)) return;
    f32x4 acc[2][2][4][2];
#pragma unroll
    for (int a = 0; a < 2; ++a)
#pragma unroll
        for (int b = 0; b < 2; ++b)
#pragma unroll
            for (int m = 0; m < 4; ++m)
#pragma unroll
                for (int n = 0; n < 2; ++n) acc[a][b][m][n] = (f32x4){0.f, 0.f, 0.f, 0.f};
    bf16x8 At[4][2], B0[2][2], B1[2][2];
    const char* cA = (const char*)g.A + (size_t)cur.pm * tstep; const char* cB = (const char*)g.Bt + (size_t)cur.pn * tstep;
    S.a_ready(cur);
    if constexpr (SP2) {
        PG8_STAGE(PG8_SB(0, 0), cB, voffB); PG8_STAGE(PG8_SB(0, 1), cB + hstep, voffB); PG8_STAGE(PG8_SA(0, 0), cA, voffA); PG8_STAGE(PG8_SA(0, 1), cA + hstep, voffA);
        if (wr == 1) PG8_BAR;
        PG8_WAIT_V(2); PG8_BAR;
        PG8_STAGE(PG8_SB(1, 0), cB + kstep, voffB); PG8_STAGE(PG8_SA(1, 0), cA + kstep, voffA); PG8_STAGE(PG8_SB(1, 1), cB + hstep + kstep, voffB);
        PG8_WAIT_V(6); PG8_BAR;
    } else {
        PG8_STAGE(PG8_SB(0, 0), cB, voffB); PG8_STAGE(PG8_SA(0, 0), cA, voffA); PG8_STAGE(PG8_SB(0, 1), cB + hstep, voffB); PG8_STAGE(PG8_SA(0, 1), cA + hstep, voffA);
        if (wr == 1) PG8_BAR;
        PG8_WAIT_V(4); PG8_BAR;
        PG8_STAGE(PG8_SB(1, 0), cB + kstep, voffB); PG8_STAGE(PG8_SA(1, 0), cA + kstep, voffA); PG8_STAGE(PG8_SB(1, 1), cB + hstep + kstep, voffB);
        PG8_WAIT_V(6); PG8_BAR;
    }
    for (;;) {
        const bool has_next = S.next(ui + 1, nxt);
        const char* nA = has_next ? (const char*)g.A + (size_t)nxt.pm * tstep : cA; const char* nB = has_next ? (const char*)g.Bt + (size_t)nxt.pn * tstep : cB;
        for (int t = 0; t < nt; t += 2) {
            const bool last = (t == nt - 2);
            const char* a1 = cA + (size_t)(t + 1) * kstep;
            const char* a2 = last ? nA : cA + (size_t)(t + 2) * kstep; const char* b2 = last ? nB : cB + (size_t)(t + 2) * kstep;
            const char* a3 = a2 + kstep; const char* b3 = b2 + kstep;
            if (last && has_next) S.a_ready(nxt);
            if constexpr (SP2) {
            PG8_LDB(B0, 0, 0); PG8_LDB(B1, 0, 1); PG8_SCHED; PG8_LDA(At, 0, 0); PG8_STAGE(PG8_SA(1, 1), a1 + hstep, voffA);
            PG8_WAIT_V(8); PG8_WAIT_L(0); PG8_BAR; PG8_MMA(0, 0, At, B0); PG8_MMA(0, 1, At, B1); PG8_BAR; PG8_SCHED;
            PG8_LDA(At, 0, 1); PG8_STAGE(PG8_SB(0, 0), b2, voffB); PG8_STAGE(PG8_SB(0, 1), b2 + hstep, voffB); PG8_STAGE(PG8_SA(0, 0), a2, voffA);
            PG8_WAIT_V(8); PG8_WAIT_L(0); PG8_BAR; PG8_MMA(1, 0, At, B0); PG8_MMA(1, 1, At, B1); PG8_BAR; PG8_SCHED;
            PG8_LDB(B0, 1, 0); PG8_LDB(B1, 1, 1); PG8_SCHED; PG8_LDA(At, 1, 0); PG8_STAGE(PG8_SA(0, 1), a2 + hstep, voffA);
            PG8_WAIT_V(8); PG8_WAIT_L(0); PG8_BAR; PG8_MMA(0, 0, At, B0); PG8_MMA(0, 1, At, B1); PG8_BAR; PG8_SCHED;
            PG8_LDA(At, 1, 1); PG8_STAGE(PG8_SB(1, 0), b3, voffB); PG8_STAGE(PG8_SB(1, 1), b3 + hstep, voffB); PG8_STAGE(PG8_SA(1, 0), a3, voffA);
            PG8_WAIT_V(8); PG8_WAIT_L(0); PG8_BAR; PG8_MMA(1, 0, At, B0); PG8_MMA(1, 1, At, B1); PG8_BAR; PG8_SCHED;
            } else {
            PG8_LDB(B0, 0, 0); PG8_SCHED; PG8_LDA(At, 0, 0); PG8_STAGE(PG8_SA(1, 1), a1 + hstep, voffA);
            PG8_WAIT_L(8); PG8_BAR; PG8_WAIT_L(0); PG8_MMA(0, 0, At, B0); PG8_BAR; PG8_SCHED;
            PG8_LDB(B1, 0, 1); PG8_STAGE(PG8_SB(0, 0), b2, voffB);
            PG8_BAR; PG8_WAIT_L(0); PG8_MMA(0, 1, At, B1); PG8_BAR;
            PG8_LDA(At, 0, 1); PG8_STAGE(PG8_SA(0, 0), a2, voffA);
            PG8_BAR; PG8_WAIT_L(0); PG8_MMA(1, 0, At, B0); PG8_BAR; PG8_SCHED;
            PG8_STAGE(PG8_SB(0, 1), b2 + hstep, voffB);
            PG8_WAIT_V(6); PG8_BAR; PG8_MMA(1, 1, At, B1); PG8_BAR;
            PG8_LDB(B0, 1, 0); PG8_SCHED; PG8_LDA(At, 1, 0); PG8_STAGE(PG8_SA(0, 1), a2 + hstep, voffA);
            PG8_WAIT_L(8); PG8_BAR; PG8_WAIT_L(0); PG8_MMA(0, 0, At, B0); PG8_BAR; PG8_SCHED;
            PG8_LDB(B1, 1, 1); PG8_STAGE(PG8_SB(1, 0), b3, voffB);
            PG8_BAR; PG8_WAIT_L(0); PG8_MMA(0, 1, At, B1); PG8_BAR;
            PG8_LDA(At, 1, 1); PG8_STAGE(PG8_SA(1, 0), a3, voffA);
            PG8_BAR; PG8_WAIT_L(0); PG8_MMA(1, 0, At, B0); PG8_BAR; PG8_SCHED;
            PG8_STAGE(PG8_SB(1, 1), b3 + hstep, voffB);
            PG8_WAIT_V(6); PG8_BAR; PG8_MMA(1, 1, At, B1); PG8_BAR;
            }
        }
        if constexpr (ALIGN_EPI) { if (wr == 0) PG8_BAR; }
        if constexpr (!Epi::AFTER_DRAIN) { E(acc, cur, wr, wc, fr, fq); S.done(cur); }
        if (!has_next) break;
#pragma unroll
        for (int a = 0; a < 2; ++a)
#pragma unroll
            for (int b = 0; b < 2; ++b)
#pragma unroll
                for (int m = 0; m < 4; ++m)
#pragma unroll
                    for (int n = 0; n < 2; ++n) acc[a][b][m][n] = (f32x4){0.f, 0.f, 0.f, 0.f};
        cur = nxt; cA = nA; cB = nB; ++ui;
        if constexpr (ALIGN_EPI) { if (wr == 1) PG8_BAR; }
    }
    PG8_WAIT_V(0);
    if constexpr (!ALIGN_EPI) { if (wr == 0) PG8_BAR; }
    PG8_BAR;
    if constexpr (Epi::AFTER_DRAIN) { E.fused(acc, cur, wr, wc, fr, fq, lds, wid, lane); S.done(cur); }
#undef PG8_SA
#undef PG8_SB
#undef PG8_STAGE
#undef PG8_LDA
#undef PG8_LDB
#undef PG8_MMA
#undef PG8_WAIT_V
#undef PG8_WAIT_L
#undef PG8_BAR
#undef PG8_SCHED
}
}

#define LAS __attribute__((address_space(3)))
typedef unsigned short bf16_t;
typedef short bf16x8 __attribute__((ext_vector_type(8)));
typedef short s16x4 __attribute__((ext_vector_type(4)));
typedef float f32x4 __attribute__((ext_vector_type(4)));
typedef float f32x2 __attribute__((ext_vector_type(2)));
typedef float f32x16 __attribute__((ext_vector_type(16)));
typedef unsigned u32x4 __attribute__((ext_vector_type(4)));
typedef unsigned u32x2 __attribute__((ext_vector_type(2)));
typedef __bf16 bf16x2_t __attribute__((ext_vector_type(2)));

constexpr int DM = 2048, NBATCH = 16, SEQ = 2048, DEPTH = 4, MTOK = NBATCH * SEQ, INC = 7168, MMEM = NBATCH * 256;
constexpr int C_NAQ = 0, C_NAK = 768, C_NAV = 1536, C_NAG = 2304, C_DLQ = 3072, C_DLK = 3840, C_DLV = 4608, C_DLG = 5376, C_MQ = 6144, C_MG = 6656;
constexpr float QSCALE = 0.08838834764831845f * 1.4426950408889634f;
constexpr float LOG2E = 1.4426950408889634f;
constexpr float NEGBIG = -1e30f, MINIT = -1e4f;
constexpr int NWAVES = 8;

constexpr size_t MiB = 1u << 20;
constexpr size_t WS_WIN = 1 * MiB, WS_WOUT = 113 * MiB, WS_WMEM = 145 * MiB, WS_MEMN = 161 * MiB, WS_MKV = 177 * MiB, WS_ROPE = 209 * MiB, WS_LSE = 210 * MiB,
                 WS_OP = 212 * MiB, WS_HY = 308 * MiB, WS_Z = 436 * MiB, WS_END = 884 * MiB;
constexpr int LDS_BYTES = 147456, RPB_OFF = 131072;

__device__ __forceinline__ unsigned pk2(float lo, float hi) { f32x2 v = {lo, hi}; bf16x2_t b = __builtin_convertvector(v, bf16x2_t); return __builtin_bit_cast(unsigned, b); }
__device__ __forceinline__ float bf_lo(unsigned u) { return __builtin_bit_cast(float, u << 16); }
__device__ __forceinline__ float bf_hi(unsigned u) { return __builtin_bit_cast(float, u & 0xffff0000u); }
__device__ __forceinline__ float wave_sum(float v) {
#pragma unroll
    for (int o = 1; o < 64; o <<= 1) v += __shfl_xor(v, o);
    return v;
}
__device__ __forceinline__ unsigned off_b(unsigned row, unsigned ch) { return 256u * row + 16u * (ch ^ (((row & 3u) << 2) | ((row >> 2) & 3u))); }
__device__ __forceinline__ s16x4 vtr(const LAS unsigned char* p) { return __builtin_amdgcn_ds_read_tr16_b64_v4i16((LAS s16x4*)p); }

struct Params {
    const float *x, *mem, *norm_g, *w_in, *na_rpb, *mem_norm_g, *w_mem_kv, *w_out, *final_g;
    float* out; unsigned char* ws;
};

template <int MODE>
__device__ __forceinline__ void transpose_item(const float* W, int K, int N, bf16_t* WT, LAS float* scr, int item, int lane) {
    const int nblk = N / 32, kb = item / nblk, nb = item % nblk, k0 = 64 * kb, n0 = 32 * nb;
    int src = n0 + (lane & 31); float sc = 1.f;
    if (MODE == 1) {
        if (n0 >= C_DLQ && n0 < C_DLV) { const int hb = n0 & ~127, j = (n0 & 127) + (lane & 31); src = hb + ((j & 1) ? 64 : 0) + (j >> 1); }
        if (n0 < C_NAK || (n0 >= C_DLQ && n0 < C_DLK) || (n0 >= C_MQ && n0 < C_MG)) sc = QSCALE;
    }
#pragma unroll 8
    for (int i = 0; i < 32; ++i) { const int kk = 2 * i + (lane >> 5); scr[kk * 33 + (lane & 31)] = W[(size_t)(k0 + kk) * N + src] * sc; }
    asm volatile("s_waitcnt lgkmcnt(0)" ::: "memory");
    const int c = lane & 7;
#pragma unroll
    for (int j = 0; j < 4; ++j) { const int n = (lane >> 3) + 8 * j; const LAS float* s = scr + (8 * c) * 33 + n;
        u32x4 o; o.x = pk2(s[0 * 33], s[1 * 33]); o.y = pk2(s[2 * 33], s[3 * 33]); o.z = pk2(s[4 * 33], s[5 * 33]); o.w = pk2(s[6 * 33], s[7 * 33]);
        *(u32x4*)(WT + (size_t)(n0 + n) * K + k0 + 8 * c) = o; }
    asm volatile("s_waitcnt lgkmcnt(0)" ::: "memory");
}
__device__ __forceinline__ void rms_row_bf16(const float* xrow, const float* g, bf16_t* orow, int lane) {
    const f32x4* xr = (const f32x4*)xrow + lane; const f32x4* gr = (const f32x4*)g + lane;
    f32x4 v[8]; float s = 0.f;
#pragma unroll
    for (int j = 0; j < 8; ++j) { v[j] = xr[64 * j]; s += (v[j].x * v[j].x + v[j].y * v[j].y) + (v[j].z * v[j].z + v[j].w * v[j].w); }
    const float rstd = 1.f / sqrtf(wave_sum(s) * (1.f / 2048.f) + 1e-6f);
    u32x2* o8 = (u32x2*)orow + lane;
#pragma unroll
    for (int j = 0; j < 8; ++j) { const f32x4 gg = gr[64 * j]; u32x2 w; w.x = pk2(v[j].x * rstd * gg.x, v[j].y * rstd * gg.y); w.y = pk2(v[j].z * rstd * gg.z, v[j].w * rstd * gg.w); o8[64 * j] = w; }
}

template <bool FINAL>
__device__ __forceinline__ void res_rms_row(const float* xin, const bf16_t* drow, const float* g, float* xout, bf16_t* hrow, int lane) {
    const f32x4* xr = (const f32x4*)xin + lane; const u32x2* dr = (const u32x2*)drow + lane; const f32x4* gr = (const f32x4*)g + lane;
    f32x4 v[8]; float s = 0.f;
#pragma unroll
    for (int j = 0; j < 8; ++j) { const u32x2 d = __builtin_nontemporal_load(dr + 64 * j); v[j] = __builtin_nontemporal_load(xr + 64 * j);
        v[j].x += bf_lo(d.x); v[j].y += bf_hi(d.x); v[j].z += bf_lo(d.y); v[j].w += bf_hi(d.y);
        s += (v[j].x * v[j].x + v[j].y * v[j].y) + (v[j].z * v[j].z + v[j].w * v[j].w); }
    const float rstd = 1.f / sqrtf(wave_sum(s) * (1.f / 2048.f) + 1e-6f);
    f32x4* xo = (f32x4*)xout + lane; u32x2* o8 = (u32x2*)hrow + lane;
#pragma unroll
    for (int j = 0; j < 8; ++j) { const f32x4 gg = gr[64 * j];
        if (FINAL) __builtin_nontemporal_store(v[j] * rstd * gg, xo + 64 * j);
        else { __builtin_nontemporal_store(v[j], xo + 64 * j); u32x2 w; w.x = pk2(v[j].x * rstd * gg.x, v[j].y * rstd * gg.y); w.y = pk2(v[j].z * rstd * gg.z, v[j].w * rstd * gg.w); o8[64 * j] = w; } }
}

template <bool FINAL>
__device__ __forceinline__ void res_rms_row2(const float* xinA, const float* xinB, const bf16_t* dA, const bf16_t* dB, const float* g, float* xoA, float* xoB, bf16_t* hA, bf16_t* hB, int lane) {
    const f32x4* xa = (const f32x4*)xinA + lane; const f32x4* xb = (const f32x4*)xinB + lane;
    const u32x2* da = (const u32x2*)dA + lane; const u32x2* db = (const u32x2*)dB + lane; const f32x4* gr = (const f32x4*)g + lane;
    f32x4 va[8], vb[8]; u32x2 ea[8], eb[8];
#pragma unroll
    for (int j = 0; j < 8; ++j) { ea[j] = __builtin_nontemporal_load(da + 64 * j); va[j] = __builtin_nontemporal_load(xa + 64 * j); }
#pragma unroll
    for (int j = 0; j < 8; ++j) { eb[j] = __builtin_nontemporal_load(db + 64 * j); vb[j] = __builtin_nontemporal_load(xb + 64 * j); }
    float sa = 0.f, sb = 0.f;
#pragma unroll
    for (int j = 0; j < 8; ++j) {
        va[j].x += bf_lo(ea[j].x); va[j].y += bf_hi(ea[j].x); va[j].z += bf_lo(ea[j].y); va[j].w += bf_hi(ea[j].y);
        vb[j].x += bf_lo(eb[j].x); vb[j].y += bf_hi(eb[j].x); vb[j].z += bf_lo(eb[j].y); vb[j].w += bf_hi(eb[j].y);
        sa += (va[j].x * va[j].x + va[j].y * va[j].y) + (va[j].z * va[j].z + va[j].w * va[j].w);
        sb += (vb[j].x * vb[j].x + vb[j].y * vb[j].y) + (vb[j].z * vb[j].z + vb[j].w * vb[j].w); }
    const float ra = 1.f / sqrtf(wave_sum(sa) * (1.f / 2048.f) + 1e-6f), rb = 1.f / sqrtf(wave_sum(sb) * (1.f / 2048.f) + 1e-6f);
    f32x4* oa = (f32x4*)xoA + lane; f32x4* ob = (f32x4*)xoB + lane; u32x2* ha = (u32x2*)hA + lane; u32x2* hb = (u32x2*)hB + lane;
#pragma unroll
    for (int j = 0; j < 8; ++j) { const f32x4 gg = gr[64 * j];
        if (FINAL) { __builtin_nontemporal_store(va[j] * ra * gg, oa + 64 * j); __builtin_nontemporal_store(vb[j] * rb * gg, ob + 64 * j); }
        else { __builtin_nontemporal_store(va[j], oa + 64 * j); __builtin_nontemporal_store(vb[j], ob + 64 * j);
            u32x2 w; w.x = pk2(va[j].x * ra * gg.x, va[j].y * ra * gg.y); w.y = pk2(va[j].z * ra * gg.z, va[j].w * ra * gg.w); ha[64 * j] = w;
            u32x2 w2; w2.x = pk2(vb[j].x * rb * gg.x, vb[j].y * rb * gg.y); w2.y = pk2(vb[j].z * rb * gg.z, vb[j].w * rb * gg.w); hb[64 * j] = w2; } }
}

enum { K_NA = 0, K_MEM = 1, K_DILP = 2, K_DILF = 3 };
struct AttnArgs { const bf16_t* Z; const bf16_t* MKV; bf16_t* Y; bf16_t* OP; float* LSE; const float* rpb; int layer; };

constexpr int ANS = 6, AD = 4, ARPB_OFF = ANS * 16384, AOST_OFF = ARPB_OFF + 11776;
#define ABAR() asm volatile("s_waitcnt lgkmcnt(0)\n\ts_barrier" ::: "memory")
#define AWAITV(n) asm volatile("s_waitcnt vmcnt(" #n ")" ::: "memory")
template <int PH> __device__ __forceinline__ int seg_kind(int s, int rot) { if (PH != 0) return K_DILF; int k = s + rot; k = k >= 3 ? k - 3 : k; return k == 0 ? K_NA : (k == 1 ? K_MEM : K_DILP); }
template <int PH> __device__ __forceinline__ int seg_items(int s, int rot) { const int k = seg_kind<PH>(s, rot); return k == K_NA ? 768 : (k == K_MEM ? 512 : (k == K_DILP ? 1536 : 768)); }

struct ALoader { int seg, it, t, NT, stg, mode, P0, L, voff, rot; bool done; const char* kbase; long rstride; unsigned goff, goff2; };

template <int PH> __device__ __forceinline__ void al_decode(ALoader& S, const AttnArgs& A, int w, int lane) {
    constexpr long PZ = (long)INC * 2, PM = 4096 * 2;
    const int kind = seg_kind<PH>(S.seg, S.rot); int item = S.it;
    if (kind == K_NA) {
        const int b = item / 48, rem = item % 48, hh = rem >> 3, R0 = 4 * (rem & 7);
        const int rs0 = min(max(R0 - 4, 0), 24), rsl = min(max(R0 - 1, 0), 24);
        S.NT = 2 * (rsl + 8 - rs0); S.mode = 3; S.rstride = PZ; S.voff = (C_NAV - C_NAK) * 2;
        S.kbase = (const char*)A.Z + ((long)b * SEQ + rs0 * 64) * PZ + (long)(C_NAK + hh * 128) * 2;
    } else if (kind == K_MEM) {
        const int b = item >> 5, rem = item & 31, hh = rem >> 3;
        S.NT = 8; S.mode = 0; S.rstride = PM; S.voff = 512 * 2;
        S.kbase = (const char*)A.MKV + (long)b * 256 * PM + (long)(A.layer * 1024 + hh * 128) * 2;
    } else {
        int cfg = 0; if (kind == K_DILP) { cfg = 1 + item / 768; item = item % 768; }
        const int b = item / 48, rem = item % 48, hh = rem >> 3, sub = rem & 7;
        const char* zb = (const char*)A.Z + (long)b * SEQ * PZ + (long)(C_DLK + hh * 128) * 2; S.voff = (C_DLV - C_DLK) * 2;
        if (cfg == 2) { S.NT = 8; S.mode = 2; S.rstride = 16 * PZ; S.kbase = zb + (long)(2 * sub) * PZ; }
        else { const int dil = cfg ? 4 : 1; int res = 0, m = sub; if (cfg == 1) { res = sub >> 1; m = sub & 1; }
            S.NT = 12; S.mode = 1; S.P0 = 256 * m; S.L = 2048 / dil; S.rstride = dil * PZ; S.kbase = zb + (long)res * PZ; }
    }
    S.goff = (unsigned)(4 * w + (lane >> 4)) * (unsigned)S.rstride + (unsigned)(((lane & 15) ^ (((lane >> 4) << 2) | (w & 3))) * 16);
    if (S.mode == 3) {
        S.goff = (unsigned)(8 * w + (lane >> 4)) * (unsigned)PZ + (unsigned)(((lane & 15) ^ (((lane >> 4) << 2) | ((2 * w) & 3))) * 16);
        S.goff2 = (unsigned)(8 * w + 4 + (lane >> 4)) * (unsigned)PZ + (unsigned)(((lane & 15) ^ (((lane >> 4) << 2) | ((2 * w + 1) & 3))) * 16); }
}
template <int PH> __device__ __forceinline__ bool al_issue(ALoader& S, LAS unsigned char* lds, const AttnArgs& A, int vcu, int w, int lane) {
    constexpr long PZ = (long)INC * 2; constexpr int NSEG = PH == 0 ? 3 : 1;
    if (S.done) return false;
    const char* p;
    if (S.mode == 0 || S.mode == 3) p = S.kbase + (long)S.t * 32 * S.rstride;
    else if (S.mode == 2) p = S.kbase + (long)(32 * (S.t & 3)) * S.rstride + (long)(S.t >> 2) * PZ;
    else { const int pos = min(max(S.P0 - 64 + 32 * S.t, 0), S.L - 32); p = S.kbase + (long)pos * S.rstride; }
    if (S.mode == 3) {
        p = S.kbase + (long)(S.t >> 1) * 64 * PZ + ((S.t & 1) ? S.voff : 0);
        LAS unsigned char* d = lds + S.stg * 16384 + w * 2048;
        __builtin_amdgcn_global_load_lds((const unsigned*)(p + S.goff), (LAS unsigned*)d, 16, 0, 0);
        __builtin_amdgcn_global_load_lds((const unsigned*)(p + S.goff2), (LAS unsigned*)(d + 1024), 16, 0, 0);
    } else {
    p += S.goff;
    LAS unsigned char* d = lds + S.stg * 16384 + w * 1024;
    __builtin_amdgcn_global_load_lds((const unsigned*)p, (LAS unsigned*)d, 16, 0, 0);
    __builtin_amdgcn_global_load_lds((const unsigned*)(p + S.voff), (LAS unsigned*)(d + 8192), 16, 0, 0);
    }
    S.stg = (S.stg + 1 == ANS) ? 0 : S.stg + 1;
    if (++S.t == S.NT) { S.t = 0; S.it += gridDim.x;
        if (S.it >= seg_items<PH>(S.seg, S.rot)) { ++S.seg; S.it = vcu; if (S.seg >= NSEG) S.done = true; }
        if (!S.done) al_decode<PH>(S, A, w, lane); }
    return true;
}

template <int PH> __device__ __forceinline__ void q_issue(bf16x8 (&qf)[8], const AttnArgs& A, int seg, int rot, int item, int w, int lane) {
    constexpr long PZ = (long)INC * 2;
    const int kind = seg_kind<PH>(seg, rot), r = lane & 31, h = lane >> 5; long tokq; int qcol;
    if (kind == K_NA) { const int b = item / 48, rem = item % 48, hh = rem >> 3, R0 = 4 * (rem & 7); tokq = (long)b * SEQ + (R0 + 2 * (w & 1) + (r >> 4)) * 64 + 16 * (w >> 1) + (r & 15); qcol = C_NAQ + hh * 128; }
    else if (kind == K_MEM) { const int b = item >> 5, rem = item & 31, hh = rem >> 3, qb = rem & 7; tokq = (long)b * SEQ + qb * 256 + 32 * w + r; qcol = C_MQ + hh * 128; }
    else { int cfg = 0, it = item; if (kind == K_DILP) { cfg = 1 + it / 768; it = it % 768; }
        const int b = it / 48, rem = it % 48, hh = rem >> 3, sub = rem & 7; qcol = C_DLQ + hh * 128;
        if (cfg == 2) tokq = (long)b * SEQ + (32 * (w & 3) + r) * 16 + 2 * sub + (w >> 2);
        else { const int dil = cfg ? 4 : 1; int res = 0, m = sub; if (cfg == 1) { res = sub >> 1; m = sub & 1; } tokq = (long)b * SEQ + (long)(256 * m + 32 * w + r) * dil + res; } }
    const char* qrow = (const char*)A.Z + tokq * PZ + (long)qcol * 2;
#pragma unroll
    for (int s = 0; s < 8; ++s) qf[s] = *(const bf16x8*)(qrow + (16 * s + 8 * h) * 2);
}

template <int PH, int KIND>
__device__ __forceinline__ void attn_item(LAS unsigned char* lds, const AttnArgs& A, ALoader& LS, int& cstg, bf16x8 (&qf)[8], int item, int nseg, int nitem, int vcu, int lane, int w) {
    constexpr long PZ = (long)INC * 2;
    const int r = lane & 31, h = lane >> 5;
    long tokq, tok0w; int qcol, gcol, ycol, hh, NT, qstr = 1;
    int cfg = 0, na_R = 0, na_rs0 = 0, na_rsw = 0, na_rsw_hi = 0, na_ks = 0, dl_P0 = 0, dl_L = 0;
    if (KIND == K_NA) {
        const int b = item / 48, rem = item % 48; hh = rem >> 3; const int R0 = 4 * (rem & 7);
        na_rs0 = min(max(R0 - 4, 0), 24); const int rsl = min(max(R0 - 1, 0), 24); NT = rsl + 8 - na_rs0;
        na_R = R0 + 2 * (w & 1); na_rsw = min(max(na_R - 4, 0), 24); na_rsw_hi = min(max(na_R - 3, 0), 24) + 8; na_ks = min(max(16 * (w >> 1) - 8, 0), 32);
        tok0w = (long)b * SEQ + na_R * 64 + 16 * (w >> 1); tokq = tok0w + (r >> 4) * 64 + (r & 15); qcol = C_NAQ + hh * 128; gcol = C_NAG + hh * 128; ycol = hh * 128;
    } else if (KIND == K_MEM) {
        const int b = item >> 5, rem = item & 31; hh = rem >> 3; const int qb = rem & 7; NT = 8;
        tok0w = (long)b * SEQ + qb * 256 + 32 * w; tokq = tok0w + r; qcol = C_MQ + hh * 128; gcol = C_MG + hh * 128; ycol = 1536 + hh * 128;
    } else {
        int it = item;
        if (KIND == K_DILP) { cfg = 1 + it / 768; it = it % 768; }
        const int b = it / 48, rem = it % 48; hh = rem >> 3; const int sub = rem & 7;
        qcol = C_DLQ + hh * 128; gcol = C_DLG + hh * 128; ycol = 768 + hh * 128;
        if (cfg == 2) {
            NT = 8; qstr = 16; tok0w = (long)b * SEQ + (32 * (w & 3)) * 16 + 2 * sub + (w >> 2); tokq = tok0w + r * 16;
        } else {
            const int dil = cfg ? 4 : 1; int res = 0, m = sub; if (cfg == 1) { res = sub >> 1; m = sub & 1; }
            dl_P0 = 256 * m; dl_L = 2048 / dil; NT = 12;
            qstr = dil; tok0w = (long)b * SEQ + (long)(dl_P0 + 32 * w) * dil + res; tokq = tok0w + (long)r * dil;
        }
    }
    auto tile_ok = [&](int t) -> bool {
        if ((KIND == K_DILP || KIND == K_DILF) && cfg != 2) { const int p = dl_P0 - 64 + 32 * t; return p >= 0 && p < dl_L; }
        return true;
    };
    auto wave_uses = [&](int t) -> bool {
        if (KIND == K_NA) { const int kr = na_rs0 + t; return kr >= na_rsw && kr < na_rsw_hi; }
        if (KIND == K_MEM) return true;
        if (cfg == 2) { const int dd = (t & 3) - (w & 3); return (t >> 2) == (w >> 2) && dd >= -2 && dd <= 2; }
        return t >= w && t <= w + 4;
    };
#pragma unroll
    for (int s = 0; s < 8; ++s) asm volatile("" : "+v"(qf[s]));
    f32x16 o[4];
#pragma unroll
    for (int c = 0; c < 4; ++c)
#pragma unroll
        for (int i = 0; i < 16; ++i) o[c][i] = 0.f;
    float mrun = MINIT, lrun = 0.f;
    const int tq = (lane & 15) >> 2, tp = lane & 3, tblk = (lane >> 4) & 1;
    const int qc = (KIND == K_NA) ? 16 * (w >> 1) + (r & 15) : 0, na_cs = min(max(qc - 8, 0), 48);
    const int na_Rq = na_R + (r >> 4), na_rsq = min(max(na_Rq - 4, 0), 24);
    const LAS float* rpbL = (const LAS float*)(lds + ARPB_OFF) + 64 + hh * 465;

#pragma unroll 1
    for (int t = 0; t < NT; ++t) {
        bool issued = al_issue<PH>(LS, lds, A, vcu, w, lane);
        if (KIND == K_NA) issued = al_issue<PH>(LS, lds, A, vcu, w, lane) && issued;
        if (tile_ok(t) && wave_uses(t)) {
            const LAS unsigned char* ldsK = lds + cstg * 16384;
            const LAS unsigned char* ldsV = (KIND == K_NA) ? lds + ((cstg + 1 == ANS) ? 0 : cstg + 1) * 16384 : ldsK + 8192;
            const int kso = (KIND == K_NA) ? na_ks : 0;
            int lr = lane; asm volatile("" : "+v"(lr));
            const int r2 = lr & 31, h2 = lr >> 5, tq2 = (lr & 15) >> 2, tp2 = lr & 3, tblk2 = (lr >> 4) & 1;
            f32x16 st;
#pragma unroll
            for (int i = 0; i < 16; ++i) st[i] = 0.f;
            bf16x8 kf[8];
#pragma unroll
            for (int s = 0; s < 8; ++s) kf[s] = *(const LAS bf16x8*)(ldsK + off_b((unsigned)(kso + r2), (unsigned)(2 * s + h2)));
            __builtin_amdgcn_sched_barrier(0);
#pragma unroll
            for (int s = 0; s < 8; ++s) st = __builtin_amdgcn_mfma_f32_32x32x16_bf16(kf[s], qf[s], st, 0, 0, 0);
            if (KIND == K_NA) {
                const int kr = na_rs0 + t, dr = kr - na_Rq + 7;
                const bool rowok = (unsigned)(kr - na_rsq) < 8u;
                const LAS float* brow = rpbL + dr * 31 + 15 - qc + na_ks + 4 * h;
                const int jrel = rowok ? na_ks + 4 * h - na_cs : 1024;
#pragma unroll
                for (int i = 0; i < 16; ++i) { const int c = (i & 3) + 8 * (i >> 2);
                    const bool ok = (unsigned)(jrel + c) < 16u;
                    const float bias = brow[c]; st[i] = ok ? st[i] + bias : NEGBIG; }
            } else if (KIND == K_DILP || KIND == K_DILF) {
                const int dt = (cfg == 2) ? ((t & 3) - (w & 3)) : (t - w - 2);
                const int d0 = 32 * dt - r;
                if (dt == -2 || dt == 2)
#pragma unroll
                for (int i = 0; i < 16; ++i) { const int j = (i & 3) + 8 * (i >> 2) + 4 * h; const int d = d0 + j;
                    const bool ok = (d >= -64) && (d <= 64); st[i] = ok ? st[i] : NEGBIG; }
            }
            float tmax = st[0];
#pragma unroll
            for (int i = 1; i < 16; ++i) tmax = fmaxf(tmax, st[i]);
            tmax = fmaxf(tmax, __shfl_xor(tmax, 32));
            const float mnew = fmaxf(mrun, tmax);
            const float alpha = __builtin_amdgcn_exp2f(mrun - mnew);
            mrun = mnew;
            float psum = 0.f;
#pragma unroll
            for (int i = 0; i < 16; ++i) { const float p = __builtin_amdgcn_exp2f(st[i] - mnew); st[i] = p; psum += p; }
            lrun = lrun * alpha + psum;
            if (__builtin_amdgcn_ballot_w64(alpha != 1.0f) != 0) {
#pragma unroll
                for (int c = 0; c < 4; ++c)
#pragma unroll
                    for (int i = 0; i < 16; ++i) o[c][i] *= alpha;
            }
            unsigned va[8]; s16x4 vv[16];
#pragma unroll
            for (int c = 0; c < 4; ++c) {
                const unsigned row0 = (unsigned)(kso + 4 * h2 + tq2), chn = (unsigned)(4 * c + 2 * tblk2 + (tp2 >> 1));
                va[2 * c] = (unsigned)(size_t)ldsV + off_b(row0, chn) + 8 * (tp2 & 1); va[2 * c + 1] = (unsigned)(size_t)ldsV + off_b(row0 + 8, chn) + 8 * (tp2 & 1);
            }
            asm volatile("ds_read_b64_tr_b16 %0, %16\n\tds_read_b64_tr_b16 %1, %17\n\tds_read_b64_tr_b16 %2, %18\n\tds_read_b64_tr_b16 %3, %19\n\t"
                         "ds_read_b64_tr_b16 %4, %20\n\tds_read_b64_tr_b16 %5, %21\n\tds_read_b64_tr_b16 %6, %22\n\tds_read_b64_tr_b16 %7, %23\n\t"
                         "ds_read_b64_tr_b16 %8, %16 offset:4096\n\tds_read_b64_tr_b16 %9, %17 offset:4096\n\tds_read_b64_tr_b16 %10, %18 offset:4096\n\tds_read_b64_tr_b16 %11, %19 offset:4096\n\t"
                         "ds_read_b64_tr_b16 %12, %20 offset:4096\n\tds_read_b64_tr_b16 %13, %21 offset:4096\n\tds_read_b64_tr_b16 %14, %22 offset:4096\n\tds_read_b64_tr_b16 %15, %23 offset:4096\n\ts_waitcnt lgkmcnt(0)"
                         : "=&v"(vv[0]), "=&v"(vv[1]), "=&v"(vv[2]), "=&v"(vv[3]), "=&v"(vv[4]), "=&v"(vv[5]), "=&v"(vv[6]), "=&v"(vv[7]),
                           "=&v"(vv[8]), "=&v"(vv[9]), "=&v"(vv[10]), "=&v"(vv[11]), "=&v"(vv[12]), "=&v"(vv[13]), "=&v"(vv[14]), "=&v"(vv[15])
                         : "v"(va[0]), "v"(va[1]), "v"(va[2]), "v"(va[3]), "v"(va[4]), "v"(va[5]), "v"(va[6]), "v"(va[7]) : "memory");
#pragma unroll
            for (int s2 = 0; s2 < 2; ++s2) {
                u32x4 pw; pw.x = pk2(st[8 * s2 + 0], st[8 * s2 + 1]); pw.y = pk2(st[8 * s2 + 2], st[8 * s2 + 3]);
                pw.z = pk2(st[8 * s2 + 4], st[8 * s2 + 5]); pw.w = pk2(st[8 * s2 + 6], st[8 * s2 + 7]);
                const bf16x8 pb = __builtin_bit_cast(bf16x8, pw);
#pragma unroll
                for (int c = 0; c < 4; ++c) {
                    const bf16x8 a = __builtin_shufflevector(vv[8 * s2 + 2 * c], vv[8 * s2 + 2 * c + 1], 0, 1, 2, 3, 4, 5, 6, 7);
                    o[c] = __builtin_amdgcn_mfma_f32_32x32x16_bf16(a, pb, o[c], 0, 0, 0);
                }
            }
        }
        if (issued) AWAITV(4); else AWAITV(0);
        ABAR();
        cstg = (cstg + 1 == ANS) ? 0 : cstg + 1;
        if (KIND == K_NA) cstg = (cstg + 1 == ANS) ? 0 : cstg + 1;
    }
    const float ltot = lrun + __shfl_xor(lrun, 32);
    const float inv = __builtin_amdgcn_rcpf(ltot);
    const float lse2 = mrun + __builtin_amdgcn_logf(ltot);
    LAS unsigned char* ost = lds + AOST_OFF + w * 4608;
    if (nseg >= 0) q_issue<PH>(qf, A, nseg, LS.rot, nitem, w, lane);
    const int ch = lane & 7;
#pragma unroll
    for (int hd = 0; hd < 2; ++hd) {
#pragma unroll
        for (int c2 = 0; c2 < 2; ++c2)
#pragma unroll
            for (int g = 0; g < 4; ++g) { const int c = 2 * hd + c2; u32x2 wv; wv.x = pk2(o[c][4 * g] * inv, o[c][4 * g + 1] * inv); wv.y = pk2(o[c][4 * g + 2] * inv, o[c][4 * g + 3] * inv);
                *(LAS u32x2*)(ost + r * 144 + (32 * c2 + 8 * g + 4 * h) * 2) = wv; }
        if (hd == 0 && (KIND == K_DILP || KIND == K_DILF)) { if (h == 0) *(LAS float*)(ost + r * 144 + 128) = lse2; }
        asm volatile("s_waitcnt lgkmcnt(0)" ::: "memory");
        u32x4 gg[4], a2[4], a3[4]; float l2[4], l3[4];
#pragma unroll
        for (int k = 0; k < 4; ++k) { const int q = (lane >> 3) + 8 * k; const long tok = tok0w + ((KIND == K_NA) ? (long)((q >> 4) * 64 + (q & 15)) : (long)q * qstr); const int dcol = 64 * hd + 8 * ch;
            if (KIND != K_DILP) gg[k] = *(const u32x4*)(A.Z + tok * INC + gcol + dcol);
            if (KIND == K_DILF) { a2[k] = *(const u32x4*)(A.OP + tok * 768 + hh * 128 + dcol); a3[k] = *(const u32x4*)(A.OP + (size_t)MTOK * 768 + tok * 768 + hh * 128 + dcol);
                l2[k] = A.LSE[tok * 6 + hh]; l3[k] = A.LSE[(size_t)MTOK * 6 + tok * 6 + hh]; } }
#pragma unroll
        for (int k = 0; k < 4; ++k) { const int q = (lane >> 3) + 8 * k; const long tok = tok0w + ((KIND == K_NA) ? (long)((q >> 4) * 64 + (q & 15)) : (long)q * qstr); const int dcol = 64 * hd + 8 * ch;
            const u32x4 ov = *(const LAS u32x4*)(ost + q * 144 + ch * 16);
            if (KIND == K_DILP) {
                *(u32x4*)(A.OP + (size_t)(cfg - 1) * ((size_t)MTOK * 768) + tok * 768 + hh * 128 + dcol) = ov;
                if (hd == 0 && ch == 0) A.LSE[(size_t)(cfg - 1) * (MTOK * 6) + tok * 6 + hh] = *(const LAS float*)(ost + q * 144 + 128);
            } else {
                float v[8] = {bf_lo(ov.x), bf_hi(ov.x), bf_lo(ov.y), bf_hi(ov.y), bf_lo(ov.z), bf_hi(ov.z), bf_lo(ov.w), bf_hi(ov.w)};
                if (KIND == K_DILF) {
                    const float l1 = *(const LAS float*)(ost + q * 144 + 128);
                    const float mx = fmaxf(l1, fmaxf(l2[k], l3[k]));
                    const float e1 = __builtin_amdgcn_exp2f(l1 - mx), e2 = __builtin_amdgcn_exp2f(l2[k] - mx), e3 = __builtin_amdgcn_exp2f(l3[k] - mx);
                    const float isum = __builtin_amdgcn_rcpf(e1 + e2 + e3); const float wa = e1 * isum, wb = e2 * isum, wc = e3 * isum;
                    v[0] = wa * v[0] + wb * bf_lo(a2[k].x) + wc * bf_lo(a3[k].x); v[1] = wa * v[1] + wb * bf_hi(a2[k].x) + wc * bf_hi(a3[k].x);
                    v[2] = wa * v[2] + wb * bf_lo(a2[k].y) + wc * bf_lo(a3[k].y); v[3] = wa * v[3] + wb * bf_hi(a2[k].y) + wc * bf_hi(a3[k].y);
                    v[4] = wa * v[4] + wb * bf_lo(a2[k].z) + wc * bf_lo(a3[k].z); v[5] = wa * v[5] + wb * bf_hi(a2[k].z) + wc * bf_hi(a3[k].z);
                    v[6] = wa * v[6] + wb * bf_lo(a2[k].w) + wc * bf_lo(a3[k].w); v[7] = wa * v[7] + wb * bf_hi(a2[k].w) + wc * bf_hi(a3[k].w);
                }
                const float g8[8] = {bf_lo(gg[k].x), bf_hi(gg[k].x), bf_lo(gg[k].y), bf_hi(gg[k].y), bf_lo(gg[k].z), bf_hi(gg[k].z), bf_lo(gg[k].w), bf_hi(gg[k].w)};
#pragma unroll
                for (int e = 0; e < 8; ++e) v[e] *= g8[e] * __builtin_amdgcn_rcpf(1.f + __builtin_amdgcn_exp2f(-LOG2E * g8[e]));
                u32x4 yv; yv.x = pk2(v[0], v[1]); yv.y = pk2(v[2], v[3]); yv.z = pk2(v[4], v[5]); yv.w = pk2(v[6], v[7]);
                *(u32x4*)(A.Y + tok * 2048 + ycol + dcol) = yv;
            }
        }
    }
}

#define RLX_AGENT __ATOMIC_RELAXED, __HIP_MEMORY_SCOPE_AGENT
#define XB_TMO      128
#define XB_XCNT(j)  (256  + 64 * (j))
#define XB_XSUB(j)  (1280 + 64 * (j))
#define XB_XGEN(j)  (2304 + 64 * (j))
#define XB_TOP      3328
#define XB_TOPGEN   3392
#define XCD_BAR_WORDS 3456
#define XB_SPIN_CAP (1u << 18)

__device__ __forceinline__ unsigned xb_ld(unsigned* p)              { return __hip_atomic_load(p, __ATOMIC_RELAXED, __HIP_MEMORY_SCOPE_AGENT); }
__device__ __forceinline__ unsigned xb_add(unsigned* p, unsigned v) { return __hip_atomic_fetch_add(p, v, __ATOMIC_RELAXED, __HIP_MEMORY_SCOPE_AGENT); }
__device__ __forceinline__ unsigned xb_xcc_id() { return (unsigned)__builtin_amdgcn_s_getreg((3 << 11) | 20) & 0xFu; }
#define XB_SPIN(cond, bar) do { unsigned _sp = 0; while (cond) { __builtin_amdgcn_s_sleep(1); \
    if ((++_sp & 255u) == 0u) { if (xb_ld(&(bar)[XB_TMO])) break; if (_sp > XB_SPIN_CAP) { atomicAdd(&(bar)[XB_TMO], 1u); break; } } } } while (0)

struct XcdBarrier {
    unsigned* bar; unsigned x;
    volatile LAS unsigned* st;
};

__device__ __forceinline__ XcdBarrier xcd_barrier_post(unsigned* bar, volatile LAS unsigned* st) {
    XcdBarrier b; b.bar = bar; b.x = xb_xcc_id(); b.st = st;
    if (threadIdx.x == 0) (void)xb_add(&bar[XB_XCNT(b.x)], 1u);
    return b;
}
__device__ __forceinline__ void xcd_barrier_complete(unsigned* bar, unsigned x, unsigned& nloc, unsigned& nx) {
    const unsigned G = gridDim.x * gridDim.y * gridDim.z;
    unsigned sum, cnt, mine, sp = 0u;
    for (;;) {
        sum = 0u; cnt = 0u; mine = 0u;
#pragma unroll
        for (unsigned j = 0; j < 16; ++j) { const unsigned c = xb_ld(&bar[XB_XCNT(j)]); sum += c; cnt += (c > 0u) ? 1u : 0u; mine = (j == x) ? c : mine; }
        if (sum == G) break;
        __builtin_amdgcn_s_sleep(1);
        if ((++sp & 255u) == 0u) { if (xb_ld(&bar[XB_TMO])) break; if (sp > XB_SPIN_CAP) { atomicAdd(&bar[XB_TMO], 1u); break; } }
    }
    nloc = mine > 0u ? mine : 1u; nx = cnt > 0u ? cnt : 1u;
}

__device__ __forceinline__ void xcd_barrier(const XcdBarrier& b) {
    asm volatile("s_waitcnt vmcnt(0)" ::: "memory");
    __syncthreads();
    if (threadIdx.x == 0) {
        unsigned* bar = b.bar;
        __builtin_amdgcn_s_waitcnt(0);
        unsigned nloc = b.st[0], nx = b.st[1];
        if (nloc == 0u) { xcd_barrier_complete(bar, b.x, nloc, nx); b.st[0] = nloc; b.st[1] = nx; }
        const unsigned old = xb_add(&bar[XB_XSUB(b.x)], 1u);
        const unsigned gen = old / nloc;
        if (old + 1u == (gen + 1u) * nloc) {
            __builtin_amdgcn_fence(__ATOMIC_RELEASE, "agent");
            asm volatile("s_waitcnt vmcnt(0)" ::: "memory");
            const unsigned og = xb_add(&bar[XB_TOP], 1u);
            const unsigned tg = og / nx;
            if (og + 1u == (tg + 1u) * nx) xb_add(&bar[XB_TOPGEN], 1u);
            else XB_SPIN(xb_ld(&bar[XB_TOPGEN]) == tg, bar);
            __builtin_amdgcn_fence(__ATOMIC_ACQUIRE, "agent");
            xb_add(&bar[XB_XGEN(b.x)], 1u);
            asm volatile("s_waitcnt vmcnt(0)" ::: "memory");
        } else {
            XB_SPIN(xb_ld(&bar[XB_XGEN(b.x)]) == gen, bar);
            __builtin_amdgcn_fence(__ATOMIC_ACQUIRE, "agent");
            asm volatile("s_waitcnt vmcnt(0)" ::: "memory");
        }
    }
    __syncthreads();
}

template <int PH>
__device__ __forceinline__ void attn_phase(LAS unsigned char* lds, const AttnArgs& A, int tid, int wid) {
    asm volatile("" : "+v"(tid));
    const int lane = tid & 63;
    const int vcu = (gridDim.x % 8 == 0) ? (blockIdx.x % 8) * (gridDim.x / 8) + blockIdx.x / 8 : blockIdx.x;
    if (PH == 0) { LAS float* rp = (LAS float*)(lds + ARPB_OFF) + 64; for (int e = tid; e < 6 * 465; e += NWAVES * 64) rp[e] = A.rpb[e] * LOG2E; }
    const int rot = PH == 0 ? (vcu >> 3) % 3 : 0;
    ALoader LS; LS.rot = rot; LS.seg = 0; LS.it = vcu; LS.t = 0; LS.stg = 0; LS.done = false; LS.P0 = 0; LS.L = 32; LS.mode = 0;
    al_decode<PH>(LS, A, wid, lane);
#pragma unroll
    for (int i = 0; i < AD; ++i) (void)al_issue<PH>(LS, lds, A, vcu, wid, lane);
    AWAITV(4); ABAR();
    int cstg = 0;
    constexpr int NSEG = PH == 0 ? 3 : 1;
    bf16x8 qf[8];
    q_issue<PH>(qf, A, 0, rot, vcu, wid, lane);
    int seg = 0, it = vcu;
#pragma unroll 1
    while (seg < NSEG) {
        int nseg = seg, nit = it + (int)gridDim.x;
        if (nit >= seg_items<PH>(seg, rot)) { nseg = seg + 1; nit = vcu; if (nseg >= NSEG) nseg = -1; }
        if (PH == 0) {
            const int kind = seg_kind<PH>(seg, rot);
            if (kind == K_NA) attn_item<PH, K_NA>(lds, A, LS, cstg, qf, it, nseg, nit, vcu, lane, wid);
            else if (kind == K_MEM) attn_item<PH, K_MEM>(lds, A, LS, cstg, qf, it, nseg, nit, vcu, lane, wid);
            else attn_item<PH, K_DILP>(lds, A, LS, cstg, qf, it, nseg, nit, vcu, lane, wid);
        } else attn_item<PH, K_DILF>(lds, A, LS, cstg, qf, it, nseg, nit, vcu, lane, wid);
        if (nseg < 0) break;
        seg = nseg; it = nit;
    }
    AWAITV(0); ABAR();
}

__global__ void __launch_bounds__(NWAVES * 64, 2) fwd_kernel(Params P) {
    extern __shared__ __attribute__((aligned(16))) unsigned char lds_raw[];
    LAS unsigned char* lds = (LAS unsigned char*)lds_raw;
    cg::grid_group grid = cg::this_grid();
    { volatile LAS unsigned* MISC0 = (volatile LAS unsigned*)(lds + LDS_BYTES - 64); if (threadIdx.x < 16) MISC0[threadIdx.x] = 0u; }
    __syncthreads();
    (void)xcd_barrier_post((unsigned*)P.ws + 4096, (volatile LAS unsigned*)(lds + LDS_BYTES - 64));
    grid.sync();
    const int wid0 = __builtin_amdgcn_readfirstlane((int)threadIdx.x >> 6);
    const int G = gridDim.x, NGW = G * NWAVES;
#define PHASE_BEGIN { unsigned char* ws = P.ws; asm volatile("" : "+s"(ws)); bf16_t* WinT = (bf16_t*)(ws + WS_WIN); bf16_t* WoutT = (bf16_t*)(ws + WS_WOUT); bf16_t* WmemT = (bf16_t*)(ws + WS_WMEM); bf16_t* MEMN = (bf16_t*)(ws + WS_MEMN); bf16_t* MKV = (bf16_t*)(ws + WS_MKV); float* ropeC = (float*)(ws + WS_ROPE); float* ropeS = ropeC + 2048 * 64; float* LSE = (float*)(ws + WS_LSE); bf16_t* OP = (bf16_t*)(ws + WS_OP); bf16_t* HB = (bf16_t*)(ws + WS_HY); bf16_t* YB = HB; bf16_t* ZB = (bf16_t*)(ws + WS_Z); (void)WinT; (void)WoutT; (void)WmemT; (void)MEMN; (void)MKV; (void)ropeS; (void)LSE; (void)OP; (void)YB; (void)ZB; int lane; asm volatile("v_mbcnt_lo_u32_b32 %0, -1, 0\n\tv_mbcnt_hi_u32_b32 %0, -1, %0" : "=&v"(lane));     const int wid = wid0, tidp = wid0 * 64 + lane, gw = blockIdx.x * NWAVES + wid; (void)gw;
#define PHASE_END(dosync) if (dosync) { XcdBarrier xb_; xb_.bar = (unsigned*)P.ws + 4096; xb_.x = xb_xcc_id(); xb_.st = (volatile LAS unsigned*)(lds + LDS_BYTES - 64); xcd_barrier(xb_); } }

    PHASE_BEGIN
      {
        LAS float* scr = (LAS float*)(lds + wid * 16384);
        constexpr int I_IN = (DM / 64) * (INC / 32), I_OUT = (DM / 64) * (DM / 32), I_MEM = (DM / 64) * (1024 / 32);
        constexpr int NITEMS = DEPTH * (I_IN + I_OUT + I_MEM);
        for (int it = gw; it < NITEMS; it += NGW) {
            int rr = it;
            if (rr < DEPTH * I_IN) { const int l = rr / I_IN; transpose_item<1>(P.w_in + (size_t)l * DM * INC, DM, INC, WinT + (size_t)l * INC * DM, scr, rr % I_IN, lane); continue; } rr -= DEPTH * I_IN;
            if (rr < DEPTH * I_OUT) { const int l = rr / I_OUT; transpose_item<0>(P.w_out + (size_t)l * DM * DM, DM, DM, WoutT + (size_t)l * DM * DM, scr, rr % I_OUT, lane); continue; } rr -= DEPTH * I_OUT;
            { const int l = rr / I_MEM; transpose_item<0>(P.w_mem_kv + (size_t)l * DM * 1024, DM, 1024, WmemT + (size_t)l * 1024 * DM, scr, rr % I_MEM, lane); }
        }
        for (int m = gw; m < MMEM; m += NGW) rms_row_bf16(P.mem + (size_t)m * DM, P.mem_norm_g, MEMN + (size_t)m * DM, lane);
        for (int m = gw; m < MTOK; m += NGW) rms_row_bf16(P.x + (size_t)m * DM, P.norm_g, HB + (size_t)m * DM, lane);
        for (int e = blockIdx.x * 512 + tidp; e < 2048 * 64; e += G * 512) { const int pos = e >> 6, i = e & 63;
            const float inv = exp2f(-(float)i * (13.287712379549449f / 64.f));
            const float ang = (float)pos * inv; float sn, cs; sincosf(ang, &sn, &cs); ropeC[e] = cs; ropeS[e] = sn; }
      }
    PHASE_END(true)

    PHASE_BEGIN
        pg8::Gemm g{MEMN, WmemT, MMEM, 4096, DM}; pg8::StaticOrder S; S.init(MMEM, 4096, G, (int)blockIdx.x);
        pg8::EpiBf16 E{MKV, 4096};
        pg8::gemm_phase<pg8::EpiBf16, pg8::StaticOrder, true, true>(lds, g, S, E, tidp);
    PHASE_END(false)

#pragma unroll 1
    for (int l = 0; l < DEPTH; ++l) {
        PHASE_BEGIN
            pg8::Gemm g{HB, WinT + (size_t)l * INC * DM, MTOK, INC, DM}; pg8::StaticOrder S; S.init(MTOK, INC, G, (int)blockIdx.x);
            pg8::EpiZ E{ZB, ropeC, ropeS};
            pg8::gemm_phase<pg8::EpiZ, pg8::StaticOrder, true, true>(lds, g, S, E, tidp);
        PHASE_END(true)
        PHASE_BEGIN
            AttnArgs A{ZB, MKV, YB, OP, LSE, P.na_rpb + (size_t)l * 6 * 465, l};
            attn_phase<0>(lds, A, tidp, wid);
        PHASE_END(true)
        PHASE_BEGIN
            AttnArgs A{ZB, MKV, YB, OP, LSE, P.na_rpb + (size_t)l * 6 * 465, l};
            attn_phase<1>(lds, A, tidp, wid);
            __syncthreads();
        PHASE_END(true)
        PHASE_BEGIN
            pg8::Gemm g{YB, WoutT + (size_t)l * DM * DM, MTOK, DM, DM}; pg8::StaticOrder S; S.init(MTOK, DM, G, (int)blockIdx.x);
            pg8::EpiBf16 E{ZB, DM};
            pg8::gemm_phase<pg8::EpiBf16, pg8::StaticOrder, true, true>(lds, g, S, E, tidp);
        PHASE_END(true)
        PHASE_BEGIN
            const float* xin = l == 0 ? P.x : (const float*)P.out;
            if (l + 1 < DEPTH) { for (int m = gw; m < MTOK; m += 2 * NGW) { const int m2 = m + NGW;
                res_rms_row2<false>(xin + (size_t)m * DM, xin + (size_t)m2 * DM, ZB + (size_t)m * DM, ZB + (size_t)m2 * DM, P.norm_g + (size_t)(l + 1) * DM, P.out + (size_t)m * DM, P.out + (size_t)m2 * DM, HB + (size_t)m * DM, HB + (size_t)m2 * DM, lane); } }
            else { for (int m = gw; m < MTOK; m += 2 * NGW) { const int m2 = m + NGW;
                res_rms_row2<true>(xin + (size_t)m * DM, xin + (size_t)m2 * DM, ZB + (size_t)m * DM, ZB + (size_t)m2 * DM, P.final_g, P.out + (size_t)m * DM, P.out + (size_t)m2 * DM, HB, HB, lane); } }
        PHASE_END(l + 1 < DEPTH)
    }
}

constexpr int N_PHASES = 2 + DEPTH * 5;

extern "C" void kernel_launch(void* const* d_in, const int* in_sizes, int n_in, void* d_out, int out_size, void* d_ws, size_t ws_size, hipStream_t stream) {
    static int grid = 0;
    if (grid == 0) {
        if (n_in != 9 || out_size != MTOK * DM || ws_size < WS_END) { fprintf(stderr, "kernel_launch: unexpected shapes (n_in %d out %d ws %zu)\n", n_in, out_size, ws_size); grid = -1; return; }
        int dev = 0, cus = 0, per_cu = 0;
        (void)hipGetDevice(&dev); (void)hipDeviceGetAttribute(&cus, hipDeviceAttributeMultiprocessorCount, dev);
        (void)hipFuncSetAttribute((const void*)fwd_kernel, hipFuncAttributeMaxDynamicSharedMemorySize, LDS_BYTES);
        (void)hipOccupancyMaxActiveBlocksPerMultiprocessor(&per_cu, (const void*)fwd_kernel, NWAVES * 64, LDS_BYTES);
        if (per_cu < 1) { fprintf(stderr, "kernel_launch: occupancy query says %d blocks/CU\n", per_cu); per_cu = 1; }
        (void)hipGetLastError();
        grid = cus * per_cu;
    }
    if (grid < 0) return;
    Params p{};
    p.x = (const float*)d_in[0]; p.mem = (const float*)d_in[1]; p.norm_g = (const float*)d_in[2]; p.w_in = (const float*)d_in[3]; p.na_rpb = (const float*)d_in[4];
    p.mem_norm_g = (const float*)d_in[5]; p.w_mem_kv = (const float*)d_in[6]; p.w_out = (const float*)d_in[7]; p.final_g = (const float*)d_in[8];
    p.out = (float*)d_out; p.ws = (unsigned char*)d_ws;
    (void)hipMemsetAsync(d_ws, 0, 65536, stream);
    void* args[] = {&p};
    hipError_t e = hipLaunchCooperativeKernel((const void*)fwd_kernel, dim3(grid), dim3(NWAVES * 64), args, LDS_BYTES, stream);
    if (e != hipSuccess) fprintf(stderr, "cooperative launch failed: %s (grid %d)\n", hipGetErrorString(e), grid);
}
```
